# Optimizing an MI355X kernel written in HIP

```python
import jax, jax.numpy as jnp
from jax import lax
import numpy as np

D_MODEL = 1024
BATCH = 4
SEQ = 4096
DEPTH = 1

PLE_DIM = 256
D_FF = 4 * D_MODEL
EPS = 1e-6
RET_HEADS = 4
RET_DK = 128
RET_DV = 256
RET_CHUNK = 128
RET_QK = RET_HEADS * RET_DK
RET_V = RET_HEADS * RET_DV
ATT_PATTERNS = ((128, 1), (512, 4), (2048, 16))
N_GROUPS = len(ATT_PATTERNS)
ATT_HEADS = 4
ATT_HD = 128
ATT_W = ATT_HEADS * ATT_HD
ROPE_THETA = 10000.0
N_BRANCH = 2
IN_SIZES = (RET_QK, RET_QK, RET_V, RET_V,
            N_GROUPS * ATT_W, N_GROUPS * ATT_W, N_GROUPS * ATT_W,
            N_BRANCH * D_MODEL)
D_IN = int(sum(IN_SIZES))
IN_OFFSETS = tuple(int(o) for o in np.cumsum(IN_SIZES)[:-1])

kernel_name = "hybrid_gated_retention_dilated_attn_block"


def rmsnorm(x, g):
    xf = x.astype(jnp.float32)
    y = xf * lax.rsqrt(jnp.mean(xf * xf, axis=-1, keepdims=True) + EPS)
    return (y * g.astype(jnp.float32)).astype(x.dtype)


def rotate(x, inv_freq):
    S = x.shape[1]
    pos = jnp.arange(S, dtype=jnp.float32)
    ang = pos[:, None] * inv_freq[None, :]
    cos = jnp.cos(ang)[:, None, :].astype(x.dtype)
    sin = jnp.sin(ang)[:, None, :].astype(x.dtype)
    x1, x2 = jnp.split(x, 2, axis=-1)
    return jnp.concatenate([x1 * cos - x2 * sin, x2 * cos + x1 * sin], axis=-1)


def retention_chunkwise(q, k, v):
    B, S, H, dk = q.shape
    dv = v.shape[-1]
    C = RET_CHUNK
    N = S // C
    dt = v.dtype
    log_g = jnp.log1p(-jnp.exp2(-5.0 - jnp.arange(H, dtype=jnp.float32)))
    idx = jnp.arange(C, dtype=jnp.float32)
    diff = idx[:, None] - idx[None, :]
    inner_decay = jnp.where(diff >= 0, jnp.exp(log_g[:, None, None] * jnp.maximum(diff, 0.0)), 0.0)
    q_decay = jnp.exp(log_g[None, :] * (idx[:, None] + 1.0))
    k_decay = jnp.exp(log_g[None, :] * (C - 1.0 - idx[:, None]))
    chunk_decay = jnp.exp(log_g * C)
    qc = q.reshape(B, N, C, H, dk)
    kc = k.reshape(B, N, C, H, dk)
    vc = v.reshape(B, N, C, H, dv)
    scores = jnp.einsum('bnihd,bnjhd->bnhij', qc, kc) * inner_decay.astype(dt)
    inner = jnp.einsum('bnhij,bnjhe->bnihe', scores, vc)
    kv = jnp.einsum('bnjhd,bnjhe->nbhde', kc * k_decay[:, :, None].astype(dt), vc).astype(jnp.float32)

    def step(state, kv_n):
        return state * chunk_decay[:, None, None] + kv_n, state

    _, prev = lax.scan(step, jnp.zeros((B, H, dk, dv), jnp.float32), kv)
    cross = jnp.einsum('bnihd,nbhde->bnihe', qc * q_decay[:, :, None].astype(dt), prev.astype(dt))
    return (inner + cross).reshape(B, S, H, dv)


def dilated_window_attention(q, k, v, window, dilation):
    B, S, H, hd = q.shape
    w_sub = window // dilation
    L = S // dilation
    nb = -(-L // w_sub)
    Lp = nb * w_sub

    def to_sub(t):
        t = t.reshape(B, L, dilation, H, hd).transpose(0, 2, 1, 3, 4)
        t = jnp.pad(t, ((0, 0), (0, 0), (0, Lp - L), (0, 0), (0, 0)))
        return t.reshape(B, dilation, nb, w_sub, H, hd)

    def with_prev(t):
        prev = jnp.pad(t, ((0, 0), (0, 0), (1, 0), (0, 0), (0, 0), (0, 0)))[:, :, :-1]
        return jnp.concatenate([prev, t], axis=3)

    qs = to_sub(q)
    kb = with_prev(to_sub(k))
    vb = with_prev(to_sub(v))
    s = jnp.einsum('brnqhd,brnkhd->brnhqk', qs, kb).astype(jnp.float32) * (hd ** -0.5)
    blk = jnp.arange(nb)[:, None]
    qpos = blk * w_sub + jnp.arange(w_sub)[None, :]
    kpos = (blk - 1) * w_sub + jnp.arange(2 * w_sub)[None, :]
    dist = qpos[:, :, None] - kpos[:, None, :]
    valid = (dist >= 0) & (dist <= w_sub) & (kpos[:, None, :] >= 0)
    s = jnp.where(valid[:, None], s, -jnp.inf)
    m = jnp.max(s, axis=-1, keepdims=True)
    e = jnp.exp(s - m)
    l = jnp.sum(e, axis=-1, keepdims=True)
    o = jnp.einsum('brnhqk,brnkhd->brnqhd', (e / l).astype(v.dtype), vb)
    lse = (m + jnp.log(l))[..., 0].transpose(0, 1, 2, 4, 3)

    def from_sub(t):
        t = t.reshape((B, dilation, Lp) + t.shape[4:])[:, :, :L]
        t = jnp.moveaxis(t, 1, 2)
        return t.reshape((B, S) + t.shape[3:])

    return from_sub(o), from_sub(lse)


def hybrid_layer(x, p_i, w_in, b_gate, g_mix, q_gain, k_gain, ret_gn, w_ret_out, w_att_out, w_o,
                 g_mlp, w_up, w_down, g_ple, w_ple_proj, w_ple_gate):
    B, S, _ = x.shape
    dt = x.dtype
    h = rmsnorm(x, g_mix)
    z = h @ w_in
    rq, rk, rv, rg, aq, ak, av, gl = jnp.split(z, IN_OFFSETS, axis=-1)

    ret_freq = 1.0 / (10000.0 ** jnp.linspace(0.0, 1.0, RET_DK // 2, dtype=jnp.float32))
    rq = rotate(rq.reshape(B, S, RET_HEADS, RET_DK), ret_freq)
    rk = rotate(rk.reshape(B, S, RET_HEADS, RET_DK), ret_freq) * (RET_DK ** -0.5)
    rv = rv.reshape(B, S, RET_HEADS, RET_DV)
    y = retention_chunkwise(rq, rk, rv)
    y = rmsnorm(y, ret_gn.reshape(RET_HEADS, RET_DV)).reshape(B, S, RET_V)
    ret_branch = (jax.nn.silu(rg) * y) @ w_ret_out

    aq = rmsnorm(aq.reshape(B, S, N_GROUPS, ATT_HEADS, ATT_HD), q_gain[:, None, :])
    ak = rmsnorm(ak.reshape(B, S, N_GROUPS, ATT_HEADS, ATT_HD), k_gain[:, None, :])
    av = av.reshape(B, S, N_GROUPS, ATT_HEADS, ATT_HD)
    rope_freq = ROPE_THETA ** (-jnp.arange(0, ATT_HD, 2, dtype=jnp.float32) / ATT_HD)
    aq = rotate(aq.reshape(B, S, N_GROUPS * ATT_HEADS, ATT_HD), rope_freq).reshape(B, S, N_GROUPS, ATT_HEADS, ATT_HD)
    ak = rotate(ak.reshape(B, S, N_GROUPS * ATT_HEADS, ATT_HD), rope_freq).reshape(B, S, N_GROUPS, ATT_HEADS, ATT_HD)
    outs, lses = [], []
    for g, (window, dilation) in enumerate(ATT_PATTERNS):
        o_g, lse_g = dilated_window_attention(aq[:, :, g], ak[:, :, g], av[:, :, g], window, dilation)
        outs.append(o_g)
        lses.append(lse_g)
    wts = jax.nn.softmax(jnp.stack(lses, axis=0), axis=0)
    o = jnp.einsum('gbsh,gbshd->bshd', wts.astype(dt), jnp.stack(outs, axis=0))
    att_branch = o.reshape(B, S, ATT_W) @ w_att_out

    gate_r, gate_a = jnp.split(jax.nn.sigmoid(gl + b_gate), N_BRANCH, axis=-1)
    x = x + (gate_r * ret_branch + gate_a * att_branch) @ w_o

    u = rmsnorm(x, g_mlp) @ w_up
    x = x + jnp.square(jax.nn.relu(u)) @ w_down

    gate_p = jax.nn.sigmoid(rmsnorm(x, g_ple) @ w_ple_gate)
    return x + gate_p * (p_i @ w_ple_proj)


def setup_inputs(seed: int = 0) -> dict:
    key = jax.random.key(seed)
    ks = jax.random.split(key, 20)
    f32 = jnp.float32

    def nrm(k, shape, scale):
        return jax.random.normal(k, shape, f32) * scale

    def gain(k, shape):
        return 1.0 + 0.02 * jax.random.normal(k, shape, f32)

    return {
        "x": nrm(ks[0], (BATCH, SEQ, D_MODEL), 1.0),
        "p": nrm(ks[1], (DEPTH, BATCH, SEQ, PLE_DIM), 1.0),
        "w_in": nrm(ks[2], (DEPTH, D_MODEL, D_IN), D_MODEL ** -0.5),
        "b_gate": nrm(ks[3], (DEPTH, N_BRANCH * D_MODEL), 0.01),
        "g_mix": gain(ks[4], (DEPTH, D_MODEL)),
        "q_gain": gain(ks[5], (DEPTH, N_GROUPS, ATT_HD)),
        "k_gain": gain(ks[6], (DEPTH, N_GROUPS, ATT_HD)),
        "ret_gn": gain(ks[7], (DEPTH, RET_V)),
        "w_ret_out": nrm(ks[8], (DEPTH, RET_V, D_MODEL), RET_V ** -0.5),
        "w_att_out": nrm(ks[9], (DEPTH, ATT_W, D_MODEL), ATT_W ** -0.5),
        "w_o": nrm(ks[10], (DEPTH, D_MODEL, D_MODEL), D_MODEL ** -0.5),
        "g_mlp": gain(ks[11], (DEPTH, D_MODEL)),
        "w_up": nrm(ks[12], (DEPTH, D_MODEL, D_FF), D_MODEL ** -0.5),
        "w_down": nrm(ks[13], (DEPTH, D_FF, D_MODEL), D_FF ** -0.5),
        "g_ple": gain(ks[14], (DEPTH, D_MODEL)),
        "w_ple_proj": nrm(ks[15], (DEPTH, PLE_DIM, D_MODEL), PLE_DIM ** -0.5),
        "w_ple_gate": nrm(ks[16], (DEPTH, D_MODEL, D_MODEL), D_MODEL ** -0.5),
    }


def reference(x, p, w_in, b_gate, g_mix, q_gain, k_gain, ret_gn, w_ret_out, w_att_out, w_o,
              g_mlp, w_up, w_down, g_ple, w_ple_proj, w_ple_gate):
    for i in range(DEPTH):
        x = hybrid_layer(x, p[i], w_in[i], b_gate[i], g_mix[i], q_gain[i], k_gain[i], ret_gn[i],
                         w_ret_out[i], w_att_out[i], w_o[i], g_mlp[i], w_up[i], w_down[i],
                         g_ple[i], w_ple_proj[i], w_ple_gate[i])
    return x
```

```cpp
#include <hip/hip_runtime.h>
#include <hip/hip_cooperative_groups.h>
#include <cstdio>
#include <cstdint>
namespace cg = cooperative_groups;
namespace pg8 {
#define PG8_LAS __attribute__((address_space(3)))
typedef unsigned short bf16_t;
typedef short bf16x8 __attribute__((ext_vector_type(8)));
typedef float f32x4 __attribute__((ext_vector_type(4)));
typedef unsigned u32x4 __attribute__((ext_vector_type(4)));
constexpr int BM = 256, BK = 64, HALF = 128, HTB = HALF * BK * 2  , STAGE_BYTES = 8 * HTB, NXCD = 8, WGM = 8;

__host__ __device__ __forceinline__ int lds_byte(int r, int c) { const int st = (r >> 4) * 2 + (c >> 5), rr = r & 15, cc = c & 31, ob = rr * 64 + cc * 2; return st * 1024 + (ob ^ (((ob >> 9) & 1) << 5)); }
__host__ __device__ __forceinline__ void stage_rc(int b, int& R, int& C) { const int st = b / 1024, sb = b % 1024, swz = sb ^ (((sb >> 9) & 1) << 5); R = (st >> 1) * 16 + swz / 64; C = (st & 1) * 32 + (swz % 64) / 2; }
__host__ __device__ __forceinline__ int perm32(int rho) { const int n = rho >> 4, i = rho & 15; return 8 * (i >> 2) + 4 * n + (i & 3); }

struct Unit { int pm, pn, kind; };
struct Gemm { const bf16_t* A; const bf16_t* Bt; int M, N, K; };

struct StaticOrder {
    int nM, nN, nwg, G, c, wgm;
    __host__ __device__ void init(int M, int N, int G_, int c_, int wgm_ = 4) { nM = M / BM; nN = N / BM; nwg = nM * nN; G = G_; c = c_; wgm = wgm_; }
    __host__ __device__ bool next(int i, Unit& u) const {
        const long L = (long)i * G + c; if (L >= nwg) return false;
        int wgid = (int)L; { const int q = nwg / NXCD, r = nwg % NXCD, xcd = wgid % NXCD, off = wgid / NXCD; wgid = (xcd < r ? xcd * (q + 1) : r * (q + 1) + (xcd - r) * q) + off; }
        const int nig = wgm * nN, gid = wgid / nig, fm = gid * wgm, gsz = (nM - fm) < wgm ? (nM - fm) : wgm;
        u.pm = fm + ((wgid % nig) % gsz); u.pn = (wgid % nig) / gsz; u.kind = 0; return true;
    }
    __device__ __forceinline__ void a_ready(const Unit&) const {}
    __device__ __forceinline__ void done(const Unit&) const {}
    __device__ __forceinline__ const char* baseA(const Gemm& g, const Unit&) const { return (const char*)g.A; }
    __device__ __forceinline__ const char* baseB(const Gemm& g, const Unit&) const { return (const char*)g.Bt; }
};
__device__ __forceinline__ unsigned cvt_pk_bf16(float lo, float hi) { unsigned r; asm volatile("v_cvt_pk_bf16_f32 %0, %1, %2" : "=v"(r) : "v"(lo), "v"(hi)); return r; }
template <class Epi, class Sched, bool ALIGN_EPI = false, bool SP2 = false>
__device__ __forceinline__ void gemm_phase(PG8_LAS unsigned char* lds, const Gemm g, const Sched& S, const Epi& E) {
    const int tid = threadIdx.x, wid = __builtin_amdgcn_readfirstlane(tid >> 6), lane = tid & 63, wr = wid >> 2, wc = wid & 3, fr = lane & 15, fq = lane >> 4;
    const int K = g.K, nt = K / BK;
    unsigned voffA[2], voffB[2];
#pragma unroll
    for (int i = 0; i < 2; ++i) { int R, C; stage_rc(tid * 16 + i * 8192, R, C); const int Rb = Epi::PERM ? ((R & ~31) + perm32(R & 31)) : R;
        voffA[i] = (unsigned)(R * K + C) * 2u; voffB[i] = (unsigned)(Rb * K + C) * 2u; }
    const size_t kstep = (size_t)(BK * 2);
    const size_t hstep = (size_t)HALF * K * 2;
    const size_t tstep = 2 * hstep;
    const unsigned ldsw = (unsigned)wid * 1024u;
    const int aoff = lds_byte(wr * 64 + fr, fq * 8), boff = lds_byte(wc * 32 + fr, fq * 8);
#define PG8_SA(b, h) (((b) * 2 + (h)) * HTB)
#define PG8_SB(b, h) ((4 + (b) * 2 + (h)) * HTB)
#define PG8_STAGE(bufoff, gbase, voff) do { _Pragma("unroll") for (int _i = 0; _i < 2; ++_i) \
        __builtin_amdgcn_global_load_lds((const unsigned*)((const char*)(gbase) + (voff)[_i]), (PG8_LAS unsigned*)(lds + (bufoff) + ldsw + _i * 8192), 16, 0, 0); } while (0)
#define PG8_LDA(dst, b, h) do { _Pragma("unroll") for (int m = 0; m < 4; ++m) _Pragma("unroll") for (int k = 0; k < 2; ++k) dst[m][k] = *(const PG8_LAS bf16x8*)(lds + PG8_SA(b, h) + aoff + m * 2048 + k * 1024); } while (0)
#define PG8_LDB(dst, b, h) do { _Pragma("unroll") for (int n = 0; n < 2; ++n) _Pragma("unroll") for (int k = 0; k < 2; ++k) dst[n][k] = *(const PG8_LAS bf16x8*)(lds + PG8_SB(b, h) + boff + n * 2048 + k * 1024); } while (0)
#define PG8_MMA(ai, bj, At, Bt) do { __builtin_amdgcn_s_setprio(1); _Pragma("unroll") for (int m = 0; m < 4; ++m) _Pragma("unroll") for (int n = 0; n < 2; ++n) _Pragma("unroll") for (int k = 0; k < 2; ++k) \
        acc[ai][bj][m][n] = __builtin_amdgcn_mfma_f32_16x16x32_bf16(Bt[n][k], At[m][k], acc[ai][bj][m][n], 0, 0, 0); __builtin_amdgcn_s_setprio(0); } while (0)
#define PG8_WAIT_V(n) asm volatile("s_waitcnt vmcnt(" #n ")" ::: "memory")
#define PG8_WAIT_L(n) asm volatile("s_waitcnt lgkmcnt(" #n ")" ::: "memory")
#define PG8_BAR __builtin_amdgcn_s_barrier()
#define PG8_SCHED __builtin_amdgcn_sched_barrier(0)
    Unit cur, nxt; int ui = 0;
    if (!S.next(0, cur)) return;
    f32x4 acc[2][2][4][2];
    E.init(acc, cur, wr, wc, fr, fq);
    bf16x8 At[4][2], B0[2][2], B1[2][2];
    const char* cA = S.baseA(g, cur) + (size_t)cur.pm * tstep; const char* cB = S.baseB(g, cur) + (size_t)cur.pn * tstep;
    S.a_ready(cur);
    if constexpr (SP2) {
        PG8_STAGE(PG8_SB(0, 0), cB, voffB); PG8_STAGE(PG8_SB(0, 1), cB + hstep, voffB); PG8_STAGE(PG8_SA(0, 0), cA, voffA); PG8_STAGE(PG8_SA(0, 1), cA + hstep, voffA);
        if (wr == 1) PG8_BAR;
        PG8_WAIT_V(2); PG8_BAR;
        PG8_STAGE(PG8_SB(1, 0), cB + kstep, voffB); PG8_STAGE(PG8_SA(1, 0), cA + kstep, voffA); PG8_STAGE(PG8_SB(1, 1), cB + hstep + kstep, voffB);
        PG8_WAIT_V(6); PG8_BAR;
    } else {
        PG8_STAGE(PG8_SB(0, 0), cB, voffB); PG8_STAGE(PG8_SA(0, 0), cA, voffA); PG8_STAGE(PG8_SB(0, 1), cB + hstep, voffB); PG8_STAGE(PG8_SA(0, 1), cA + hstep, voffA);
        if (wr == 1) PG8_BAR;
        PG8_WAIT_V(4); PG8_BAR;
        PG8_STAGE(PG8_SB(1, 0), cB + kstep, voffB); PG8_STAGE(PG8_SA(1, 0), cA + kstep, voffA); PG8_STAGE(PG8_SB(1, 1), cB + hstep + kstep, voffB);
        PG8_WAIT_V(6); PG8_BAR;
    }
    for (;;) {
        const bool has_next = S.next(ui + 1, nxt);
        const char* nA = has_next ? S.baseA(g, nxt) + (size_t)nxt.pm * tstep : cA; const char* nB = has_next ? S.baseB(g, nxt) + (size_t)nxt.pn * tstep : cB;
        for (int t = 0; t < nt; t += 2) {
            const bool last = (t == nt - 2);
            const char* a1 = cA + (size_t)(t + 1) * kstep;
            const char* a2 = last ? nA : cA + (size_t)(t + 2) * kstep; const char* b2 = last ? nB : cB + (size_t)(t + 2) * kstep;
            const char* a3 = a2 + kstep; const char* b3 = b2 + kstep;
            if (last && has_next) S.a_ready(nxt);
            if constexpr (SP2) {
            PG8_LDB(B0, 0, 0); PG8_LDB(B1, 0, 1); PG8_SCHED; PG8_LDA(At, 0, 0); PG8_STAGE(PG8_SA(1, 1), a1 + hstep, voffA);
            PG8_WAIT_V(8); PG8_WAIT_L(0); PG8_BAR; PG8_MMA(0, 0, At, B0); PG8_MMA(0, 1, At, B1); PG8_BAR; PG8_SCHED;
            PG8_LDA(At, 0, 1); PG8_STAGE(PG8_SB(0, 0), b2, voffB); PG8_STAGE(PG8_SB(0, 1), b2 + hstep, voffB); PG8_STAGE(PG8_SA(0, 0), a2, voffA);
            PG8_WAIT_V(8); PG8_WAIT_L(0); PG8_BAR; PG8_MMA(1, 0, At, B0); PG8_MMA(1, 1, At, B1); PG8_BAR; PG8_SCHED;
            PG8_LDB(B0, 1, 0); PG8_LDB(B1, 1, 1); PG8_SCHED; PG8_LDA(At, 1, 0); PG8_STAGE(PG8_SA(0, 1), a2 + hstep, voffA);
            PG8_WAIT_V(8); PG8_WAIT_L(0); PG8_BAR; PG8_MMA(0, 0, At, B0); PG8_MMA(0, 1, At, B1); PG8_BAR; PG8_SCHED;
            PG8_LDA(At, 1, 1); PG8_STAGE(PG8_SB(1, 0), b3, voffB); PG8_STAGE(PG8_SB(1, 1), b3 + hstep, voffB); PG8_STAGE(PG8_SA(1, 0), a3, voffA);
            PG8_WAIT_V(8); PG8_WAIT_L(0); PG8_BAR; PG8_MMA(1, 0, At, B0); PG8_MMA(1, 1, At, B1); PG8_BAR; PG8_SCHED;
            } else {
            PG8_LDB(B0, 0, 0); PG8_SCHED; PG8_LDA(At, 0, 0); PG8_STAGE(PG8_SA(1, 1), a1 + hstep, voffA);
            PG8_WAIT_L(8); PG8_BAR; PG8_WAIT_L(0); PG8_MMA(0, 0, At, B0); PG8_BAR; PG8_SCHED;
            PG8_LDB(B1, 0, 1); PG8_STAGE(PG8_SB(0, 0), b2, voffB);
            PG8_BAR; PG8_WAIT_L(0); PG8_MMA(0, 1, At, B1); PG8_BAR;
            PG8_LDA(At, 0, 1); PG8_STAGE(PG8_SA(0, 0), a2, voffA);
            PG8_BAR; PG8_WAIT_L(0); PG8_MMA(1, 0, At, B0); PG8_BAR; PG8_SCHED;
            PG8_STAGE(PG8_SB(0, 1), b2 + hstep, voffB);
            PG8_WAIT_V(6); PG8_BAR; PG8_MMA(1, 1, At, B1); PG8_BAR;
            PG8_LDB(B0, 1, 0); PG8_SCHED; PG8_LDA(At, 1, 0); PG8_STAGE(PG8_SA(0, 1), a2 + hstep, voffA);
            PG8_WAIT_L(8); PG8_BAR; PG8_WAIT_L(0); PG8_MMA(0, 0, At, B0); PG8_BAR; PG8_SCHED;
            PG8_LDB(B1, 1, 1); PG8_STAGE(PG8_SB(1, 0), b3, voffB);
            PG8_BAR; PG8_WAIT_L(0); PG8_MMA(0, 1, At, B1); PG8_BAR;
            PG8_LDA(At, 1, 1); PG8_STAGE(PG8_SA(1, 0), a3, voffA);
            PG8_BAR; PG8_WAIT_L(0); PG8_MMA(1, 0, At, B0); PG8_BAR; PG8_SCHED;
            PG8_STAGE(PG8_SB(1, 1), b3 + hstep, voffB);
            PG8_WAIT_V(6); PG8_BAR; PG8_MMA(1, 1, At, B1); PG8_BAR;
            }
        }
        if constexpr (ALIGN_EPI) { if (wr == 0) PG8_BAR; }
        if constexpr (!Epi::AFTER_DRAIN) { E(acc, cur, wr, wc, fr, fq); S.done(cur); }
        if (!has_next) break;
        E.init(acc, nxt, wr, wc, fr, fq);
        cur = nxt; cA = nA; cB = nB; ++ui;
        if constexpr (ALIGN_EPI) { if (wr == 1) PG8_BAR; }
    }
    PG8_WAIT_V(0);
    if constexpr (!ALIGN_EPI) { if (wr == 0) PG8_BAR; }
    PG8_BAR;
    if constexpr (Epi::AFTER_DRAIN) { E.fused(acc, cur, wr, wc, fr, fq, lds, wid, lane); S.done(cur); }
#undef PG8_SA
#undef PG8_SB
#undef PG8_STAGE
#undef PG8_LDA
#undef PG8_LDB
#undef PG8_MMA
#undef PG8_WAIT_V
#undef PG8_WAIT_L
#undef PG8_BAR
#undef PG8_SCHED
}
}

#define LAS __attribute__((address_space(3)))
typedef unsigned short bf16_t;
typedef short bf16x8 __attribute__((ext_vector_type(8)));
typedef short s16x4 __attribute__((ext_vector_type(4)));
typedef float f32x4 __attribute__((ext_vector_type(4)));
typedef unsigned u32x4 __attribute__((ext_vector_type(4)));
typedef unsigned u32x2 __attribute__((ext_vector_type(2)));

constexpr int NB = 4, SEQ = 4096, DM = 1024, MTOK = NB * SEQ, DIN = 9728, DFF = 4096, PLE = 256;
constexpr int ZR_W = 3072;
constexpr int ZA_W = 4608;
constexpr int GL_W = 2048;
constexpr float EPSN = 1e-6f;
constexpr float LOG2E = 1.4426950408889634f;
constexpr float INV2PI = 0.15915494309189535f;
constexpr float QK_SCALE = 0.08838834764831845f;
constexpr float LOG2_THETA = 13.287712379549449f;

constexpr size_t MiB = 1u << 20;
constexpr size_t WS_WIN = 0, WS_WRET = 19 * MiB, WS_WATT = 21 * MiB, WS_WO = 22 * MiB, WS_WUP = 24 * MiB, WS_WDN = 32 * MiB, WS_WPG = 40 * MiB, WS_WPP = 42 * MiB;
constexpr size_t WS_PBF = 43 * MiB;
constexpr size_t WS_H = 52 * MiB;
constexpr size_t WS_Z = 84 * MiB;
constexpr size_t WS_PREV = 180 * MiB;
constexpr size_t WS_MERGED = 148 * MiB;
constexpr size_t WS_PP = 212 * MiB;
constexpr size_t WS_LSE = 244 * MiB;
constexpr size_t WS_SSQ1 = 245 * MiB, WS_SSQ2 = 246 * MiB;
constexpr size_t WS_BAR = 247 * MiB, BAR_STRIDE = 16384, BAR_MAXL = 8;
constexpr size_t WS_END = 248 * MiB;
constexpr int LDS_BYTES = 163840;

__device__ __forceinline__ float bf2f(unsigned v) { return __builtin_bit_cast(float, v << 16); }
__device__ __forceinline__ unsigned f2bf(float f) { unsigned u = __builtin_bit_cast(unsigned, f); return (u + 0x7fffu + ((u >> 16) & 1u)) >> 16; }
typedef __bf16 bf16x2_hw __attribute__((ext_vector_type(2)));
typedef float f32x2_hw __attribute__((ext_vector_type(2)));
__device__ __forceinline__ unsigned pk2(float lo, float hi) { const f32x2_hw v = {lo, hi}; return __builtin_bit_cast(unsigned, __builtin_convertvector(v, bf16x2_hw)); }
__device__ __forceinline__ float lo16(unsigned w) { return __builtin_bit_cast(float, w << 16); }
__device__ __forceinline__ float hi16(unsigned w) { return __builtin_bit_cast(float, w & 0xffff0000u); }
__device__ __forceinline__ float sigmoidf_(float x) { return __builtin_amdgcn_rcpf(1.f + __builtin_amdgcn_exp2f(-LOG2E * x)); }
__device__ __forceinline__ float ret_lg2(int h) { return h == 0 ? -0.04580368961312479f : (h == 1 ? -0.02272007650008353f : (h == 2 ? -0.011315313227834146f : -0.005646563141142063f)); }
__device__ __forceinline__ s16x4 tr4(const LAS unsigned char* p) { return __builtin_bit_cast(s16x4, __builtin_amdgcn_ds_read_tr16_b64_v4i16((LAS s16x4*)p)); }
__device__ __forceinline__ bf16x8 cat8(s16x4 a, s16x4 b) { return __builtin_shufflevector(a, b, 0, 1, 2, 3, 4, 5, 6, 7); }
__device__ __forceinline__ f32x4 mfma16(bf16x8 a, bf16x8 b, f32x4 c) { return __builtin_amdgcn_mfma_f32_16x16x32_bf16(a, b, c, 0, 0, 0); }

template <int MODE> struct Epi {
    static constexpr bool PERM = true, AFTER_DRAIN = false;
    bf16_t* O; int ldc;
    bf16_t* SCR;
    const float* bias;
    const float* Xin; float* Xout;
    const float* gvec;
    float* Pout; const float* Pin;
    const bf16_t* PP;
    __device__ __forceinline__ void init(pg8::f32x4 (&acc)[2][2][4][2], const pg8::Unit& u, int wr, int wc, int fr, int fq) const {
        if (MODE == 4) {
            const int row0 = u.pm * 256 + wr * 64 + fr, col0 = u.pn * 256 + wc * 32 + 8 * fq;
#pragma unroll
            for (int a = 0; a < 2; ++a)
#pragma unroll
                for (int m = 0; m < 4; ++m)
#pragma unroll
                    for (int b = 0; b < 2; ++b) {
                        const float* xp = Xin + (size_t)(row0 + a * 128 + m * 16) * DM + col0 + b * 128;
                        acc[a][b][m][0] = *(const pg8::f32x4*)xp; acc[a][b][m][1] = *(const pg8::f32x4*)(xp + 4);
                    }
        } else {
#pragma unroll
            for (int a = 0; a < 2; ++a)
#pragma unroll
                for (int b = 0; b < 2; ++b)
#pragma unroll
                    for (int m = 0; m < 4; ++m)
#pragma unroll
                        for (int n = 0; n < 2; ++n) acc[a][b][m][n] = (pg8::f32x4){0.f, 0.f, 0.f, 0.f};
        }
    }
    __device__ __forceinline__ void operator()(const pg8::f32x4 (&acc)[2][2][4][2], const pg8::Unit& u, int wr, int wc, int fr, int fq) const {
        const int row0 = u.pm * 256 + wr * 64 + fr;
        const int col0 = u.pn * 256 + wc * 32 + 8 * fq;
        if (MODE == 7) {
#pragma unroll
            for (int ai = 0; ai < 2; ++ai) {
                float rsq[4];
                {
                    f32x4 t[4][4];
#pragma unroll
                    for (int m = 0; m < 4; ++m) { const f32x4* pp4 = (const f32x4*)(Pin + (size_t)(row0 + ai * 128 + m * 16) * 16); t[m][0] = pp4[0]; t[m][1] = pp4[1]; t[m][2] = pp4[2]; t[m][3] = pp4[3]; }
#pragma unroll
                    for (int m = 0; m < 4; ++m) {
                        const float sq = ((t[m][0][0] + t[m][0][1]) + (t[m][0][2] + t[m][0][3])) + ((t[m][1][0] + t[m][1][1]) + (t[m][1][2] + t[m][1][3])) + ((t[m][2][0] + t[m][2][1]) + (t[m][2][2] + t[m][2][3])) + ((t[m][3][0] + t[m][3][1]) + (t[m][3][2] + t[m][3][3]));
                        rsq[m] = rsqrtf(sq * (1.f / 1024.f) + EPSN);
                    }
                }
#pragma unroll
                for (int mh = 0; mh < 2; ++mh) {
                    f32x4 x0[4], x1[4]; u32x4 pq[4];
#pragma unroll
                    for (int q = 0; q < 4; ++q) {
                        const int m = 2 * mh + (q >> 1), bj = q & 1;
                        const size_t off = (size_t)(row0 + ai * 128 + m * 16) * DM + col0 + bj * 128;
                        x0[q] = *(const f32x4*)(Xin + off); x1[q] = *(const f32x4*)(Xin + off + 4); pq[q] = *(const u32x4*)(PP + off);
                    }
#pragma unroll
                    for (int q = 0; q < 4; ++q) {
                        const int m = 2 * mh + (q >> 1), bj = q & 1;
                        const size_t off = (size_t)(row0 + ai * 128 + m * 16) * DM + col0 + bj * 128;
                        const float rs = rsq[m];
                        const pg8::f32x4 v0 = acc[ai][bj][m][0], v1 = acc[ai][bj][m][1];
                        const u32x4 p = pq[q];
                        const float pv[8] = {lo16(p.x), hi16(p.x), lo16(p.y), hi16(p.y), lo16(p.z), hi16(p.z), lo16(p.w), hi16(p.w)};
                        f32x4 y0, y1;
#pragma unroll
                        for (int e = 0; e < 4; ++e) { y0[e] = x0[q][e] + sigmoidf_(v0[e] * rs) * pv[e]; y1[e] = x1[q][e] + sigmoidf_(v1[e] * rs) * pv[4 + e]; }
                        *(f32x4*)(Xout + off) = y0; *(f32x4*)(Xout + off + 4) = y1;
                    }
                }
            }
            return;
        }
        if (MODE == 6 || MODE == 3) {
            u32x4* sp = (u32x4*)SCR + ((wr * 4 + wc) * 64 + fq * 16 + fr) + ((MODE == 3 || (MODE == 6 && u.kind == 1)) ? 8192 : 0);
            if (MODE == 6 && u.kind != 2) {
                const float* bp = bias + (u.kind == 0 ? 0 : 1024) + col0;
#pragma unroll
                for (int bj = 0; bj < 2; ++bj) {
                    const f32x4 b0 = *(const f32x4*)(bp + bj * 128), b1 = *(const f32x4*)(bp + bj * 128 + 4);
#pragma unroll
                    for (int ai = 0; ai < 2; ++ai)
#pragma unroll
                        for (int m = 0; m < 4; ++m) {
                            const pg8::f32x4 v0 = acc[ai][bj][m][0], v1 = acc[ai][bj][m][1];
                            u32x4 w; w.x = pk2(sigmoidf_(v0[0] + b0[0]), sigmoidf_(v0[1] + b0[1])); w.y = pk2(sigmoidf_(v0[2] + b0[2]), sigmoidf_(v0[3] + b0[3]));
                            w.z = pk2(sigmoidf_(v1[0] + b1[0]), sigmoidf_(v1[1] + b1[1])); w.w = pk2(sigmoidf_(v1[2] + b1[2]), sigmoidf_(v1[3] + b1[3]));
                            sp[((ai * 4 + m) * 2 + bj) * 512] = w;
                        }
                }
            } else {
#pragma unroll
                for (int ai = 0; ai < 2; ++ai)
#pragma unroll
                    for (int mh = 0; mh < 2; ++mh) {
                        u32x4 gq[4], pq[4];
#pragma unroll
                        for (int q = 0; q < 4; ++q) {
                            const int m = 2 * mh + (q >> 1), bj = q & 1;
                            gq[q] = sp[((ai * 4 + m) * 2 + bj) * 512];
                            if (MODE == 3) pq[q] = *(const u32x4*)(O + (size_t)(row0 + ai * 128 + m * 16) * ldc + col0 + bj * 128);
                        }
#pragma unroll
                        for (int q = 0; q < 4; ++q) {
                            const int m = 2 * mh + (q >> 1), bj = q & 1;
                            bf16_t* op = O + (size_t)(row0 + ai * 128 + m * 16) * ldc + col0 + bj * 128;
                            const u32x4 g = gq[q];
                            const pg8::f32x4 v0 = acc[ai][bj][m][0], v1 = acc[ai][bj][m][1];
                            float r[8] = {lo16(g.x) * v0[0], hi16(g.x) * v0[1], lo16(g.y) * v0[2], hi16(g.y) * v0[3], lo16(g.z) * v1[0], hi16(g.z) * v1[1], lo16(g.w) * v1[2], hi16(g.w) * v1[3]};
                            if (MODE == 3) {
                                const u32x4 p = pq[q];
                                r[0] += lo16(p.x); r[1] += hi16(p.x); r[2] += lo16(p.y); r[3] += hi16(p.y); r[4] += lo16(p.z); r[5] += hi16(p.z); r[6] += lo16(p.w); r[7] += hi16(p.w);
                            }
                            u32x4 w; w.x = pk2(r[0], r[1]); w.y = pk2(r[2], r[3]); w.z = pk2(r[4], r[5]); w.w = pk2(r[6], r[7]);
                            *(u32x4*)op = w;
                        }
                    }
            }
            return;
        }
        f32x4 gv4[2][2];
        if (MODE == 4) {
#pragma unroll
            for (int bj = 0; bj < 2; ++bj) { gv4[bj][0] = *(const f32x4*)(gvec + col0 + bj * 128); gv4[bj][1] = *(const f32x4*)(gvec + col0 + bj * 128 + 4); }
        }
#pragma unroll
        for (int ai = 0; ai < 2; ++ai)
#pragma unroll
            for (int m = 0; m < 4; ++m) {
                const int row = row0 + ai * 128 + m * 16;
                float rs = 1.f;
                if (MODE == 5 || MODE == 7) {
                    const f32x4* pp = (const f32x4*)(Pin + (size_t)row * 16);
                    f32x4 a = pp[0], b = pp[1], c = pp[2], d = pp[3];
                    float s = ((a[0] + a[1]) + (a[2] + a[3])) + ((b[0] + b[1]) + (b[2] + b[3])) + ((c[0] + c[1]) + (c[2] + c[3])) + ((d[0] + d[1]) + (d[2] + d[3]));
                    rs = rsqrtf(s * (1.f / 1024.f) + EPSN);
                }
                float ssq = 0.f;
#pragma unroll
                for (int bj = 0; bj < 2; ++bj) {
                    const int col = col0 + bj * 128;
                    float v[8];
#pragma unroll
                    for (int e = 0; e < 4; ++e) { v[e] = acc[ai][bj][m][0][e]; v[4 + e] = acc[ai][bj][m][1][e]; }
                    if (MODE == 0) {
                        u32x4 w; w.x = pk2(v[0], v[1]); w.y = pk2(v[2], v[3]); w.z = pk2(v[4], v[5]); w.w = pk2(v[6], v[7]);
                        *(u32x4*)(O + (size_t)row * ldc + col) = w;
                    } else if (MODE == 4) {
                        const f32x4 g0 = gv4[bj][0], g1 = gv4[bj][1];
                        f32x4 y0, y1;
#pragma unroll
                        for (int e = 0; e < 4; ++e) { y0[e] = v[e]; y1[e] = v[4 + e]; ssq += y0[e] * y0[e] + y1[e] * y1[e]; }
                        *(f32x4*)(Xout + (size_t)row * DM + col) = y0; *(f32x4*)(Xout + (size_t)row * DM + col + 4) = y1;
                        u32x4 w; w.x = pk2(y0[0] * g0[0], y0[1] * g0[1]); w.y = pk2(y0[2] * g0[2], y0[3] * g0[3]); w.z = pk2(y1[0] * g1[0], y1[1] * g1[1]); w.w = pk2(y1[2] * g1[2], y1[3] * g1[3]);
                        *(u32x4*)(O + (size_t)row * ldc + col) = w;
                    } else if (MODE == 5) {
                        float r[8];
#pragma unroll
                        for (int e = 0; e < 8; ++e) { const float t = fmaxf(v[e] * rs, 0.f); r[e] = t * t; }
                        u32x4 w; w.x = pk2(r[0], r[1]); w.y = pk2(r[2], r[3]); w.z = pk2(r[4], r[5]); w.w = pk2(r[6], r[7]);
                        *(u32x4*)(O + (size_t)row * ldc + col) = w;
                    } else if (MODE == 7) {
                        const u32x4 p = *(const u32x4*)(PP + (size_t)row * DM + col);
                        const f32x4 x0 = *(const f32x4*)(Xin + (size_t)row * DM + col), x1 = *(const f32x4*)(Xin + (size_t)row * DM + col + 4);
                        const float pv[8] = {lo16(p.x), hi16(p.x), lo16(p.y), hi16(p.y), lo16(p.z), hi16(p.z), lo16(p.w), hi16(p.w)};
                        f32x4 y0, y1;
#pragma unroll
                        for (int e = 0; e < 4; ++e) { y0[e] = x0[e] + sigmoidf_(v[e] * rs) * pv[e]; y1[e] = x1[e] + sigmoidf_(v[4 + e] * rs) * pv[4 + e]; }
                        *(f32x4*)(Xout + (size_t)row * DM + col) = y0; *(f32x4*)(Xout + (size_t)row * DM + col + 4) = y1;
                    }
                }
                if (MODE == 4) {
                    ssq += __shfl_xor(ssq, 16); ssq += __shfl_xor(ssq, 32);
                    if (fq == 0) Pout[(size_t)row * 16 + u.pn * 4 + wc] = ssq;
                }
            }
    }
};


struct EpiHead {
    static constexpr bool PERM = true, AFTER_DRAIN = false;
    bf16_t* O; int ldc; int nrot; int sc_lo, sc_hi; int norm; const float* qgain; const float* kgain; float fdiv; LAS float* X;
    __device__ __forceinline__ void init(pg8::f32x4 (&acc)[2][2][4][2], const pg8::Unit& u, int wr, int wc, int fr, int fq) const {
#pragma unroll
        for (int a = 0; a < 2; ++a)
#pragma unroll
            for (int b = 0; b < 2; ++b)
#pragma unroll
                for (int m = 0; m < 4; ++m)
#pragma unroll
                    for (int n = 0; n < 2; ++n) acc[a][b][m][n] = (pg8::f32x4){0.f, 0.f, 0.f, 0.f};
    }
    __device__ __forceinline__ void operator()(const pg8::f32x4 (&acc)[2][2][4][2], const pg8::Unit& u, int wr, int wc, int fr, int fq) const {
        const int row0 = u.pm * 256 + wr * 64 + fr;
        if (u.pn >= nrot) {
            const int col0 = u.pn * 256 + wc * 32 + 8 * fq;
#pragma unroll
            for (int ai = 0; ai < 2; ++ai)
#pragma unroll
                for (int m = 0; m < 4; ++m)
#pragma unroll
                    for (int bj = 0; bj < 2; ++bj) {
                        u32x4 w; w.x = pk2(acc[ai][bj][m][0][0], acc[ai][bj][m][0][1]); w.y = pk2(acc[ai][bj][m][0][2], acc[ai][bj][m][0][3]);
                        w.z = pk2(acc[ai][bj][m][1][0], acc[ai][bj][m][1][1]); w.w = pk2(acc[ai][bj][m][1][2], acc[ai][bj][m][1][3]);
                        *(u32x4*)(O + (size_t)(row0 + ai * 128 + m * 16) * ldc + col0 + bj * 128) = w;
                    }
            return;
        }
        const int u4 = wc * 4 + fq;
        float fr4[4];
#pragma unroll
        for (int e = 0; e < 4; ++e) fr4[e] = exp2f(-(float)(4 * u4 + e) * (LOG2_THETA / fdiv)) * INV2PI;
        const float sc = (u.pn >= sc_lo && u.pn < sc_hi) ? QK_SCALE : 1.f;
        if (norm) {
#pragma unroll
            for (int ai = 0; ai < 2; ++ai)
#pragma unroll
                for (int m = 0; m < 4; ++m)
#pragma unroll
                    for (int bj = 0; bj < 2; ++bj) {
                        float s = 0.f;
#pragma unroll
                        for (int e = 0; e < 4; ++e) s += acc[ai][bj][m][0][e] * acc[ai][bj][m][0][e] + acc[ai][bj][m][1][e] * acc[ai][bj][m][1][e];
                        s += __shfl_xor(s, 16); s += __shfl_xor(s, 32);
                        if (fq == 0) X[((ai * 128 + wr * 64 + m * 16 + fr) * 2 + bj) * 4 + wc] = s;
                    }
            asm volatile("s_waitcnt lgkmcnt(0)" ::: "memory");
            __builtin_amdgcn_s_barrier();
        }
        f32x4 gh[2][2];
        if (norm) {
#pragma unroll
            for (int bj = 0; bj < 2; ++bj) { const int hb = u.pn * 256 + bj * 128;
                const float* gp = (hb < 1536 ? qgain + (hb >> 9) * 128 : kgain + ((hb - 1536) >> 9) * 128) + 4 * u4;
                gh[bj][0] = *(const f32x4*)gp; gh[bj][1] = *(const f32x4*)(gp + 64); }
        }
#pragma unroll
        for (int ai = 0; ai < 2; ++ai)
#pragma unroll
            for (int m = 0; m < 4; ++m) {
                const int row = row0 + ai * 128 + m * 16;
                const float pos = (float)(row & (SEQ - 1));
                float cs[4], sn[4];
#pragma unroll
                for (int e = 0; e < 4; ++e) { float r = pos * fr4[e]; r -= floorf(r); cs[e] = __builtin_amdgcn_cosf(r); sn[e] = __builtin_amdgcn_sinf(r); }
#pragma unroll
                for (int bj = 0; bj < 2; ++bj) {
                    const int hb = u.pn * 256 + bj * 128;
                    float x1[4], x2[4];
#pragma unroll
                    for (int e = 0; e < 4; ++e) { x1[e] = acc[ai][bj][m][0][e] * sc; x2[e] = acc[ai][bj][m][1][e] * sc; }
                    if (norm) {
                        const f32x4 pr = *(const LAS f32x4*)(X + ((ai * 128 + wr * 64 + m * 16 + fr) * 2 + bj) * 4);
                        const float rstd = rsqrtf(((pr[0] + pr[1]) + (pr[2] + pr[3])) * (1.f / 128.f) + EPSN);
                        const f32x4 g1 = gh[bj][0], g2 = gh[bj][1];
#pragma unroll
                        for (int e = 0; e < 4; ++e) { x1[e] *= rstd * g1[e]; x2[e] *= rstd * g2[e]; }
                    }
                    u32x2 w1, w2;
                    w1.x = pk2(x1[0] * cs[0] - x2[0] * sn[0], x1[1] * cs[1] - x2[1] * sn[1]); w1.y = pk2(x1[2] * cs[2] - x2[2] * sn[2], x1[3] * cs[3] - x2[3] * sn[3]);
                    w2.x = pk2(x2[0] * cs[0] + x1[0] * sn[0], x2[1] * cs[1] + x1[1] * sn[1]); w2.y = pk2(x2[2] * cs[2] + x1[2] * sn[2], x2[3] * cs[3] + x1[3] * sn[3]);
                    bf16_t* op = O + (size_t)row * ldc + hb + 4 * u4;
                    const auto s0 = __builtin_amdgcn_permlane16_swap(w1.x, w2.x, false, false);
                    const auto s1 = __builtin_amdgcn_permlane16_swap(w1.y, w2.y, false, false);
                    u32x4 wv; wv.x = s0[0]; wv.y = s1[0]; wv.z = s0[1]; wv.w = s1[1];
                    *(u32x4*)(op + ((fq & 1) ? 60 : 0)) = wv;
                }
            }
    }
};

#define XB_TMO      128
#define XB_XCNT(j)  (256  + 64 * (j))
#define XB_XSUB(j)  (1280 + 64 * (j))
#define XB_XGEN(j)  (2304 + 64 * (j))
#define XB_TOP      3328
#define XB_TOPGEN   3392
#define XCD_BAR_WORDS 3456
#define XB_SPIN_CAP (1u << 18)

__device__ __forceinline__ unsigned xb_ld(unsigned* p)              { return __hip_atomic_load(p, __ATOMIC_RELAXED, __HIP_MEMORY_SCOPE_AGENT); }
__device__ __forceinline__ unsigned xb_add(unsigned* p, unsigned v) { return __hip_atomic_fetch_add(p, v, __ATOMIC_RELAXED, __HIP_MEMORY_SCOPE_AGENT); }
__device__ __forceinline__ unsigned xb_xcc_id() { return (unsigned)__builtin_amdgcn_s_getreg((3 << 11) | 20) & 0xFu; }
#define XB_SPIN(cond, bar) do { unsigned _sp = 0; while (cond) { __builtin_amdgcn_s_sleep(1); \
    if ((++_sp & 255u) == 0u) { if (xb_ld(&(bar)[XB_TMO])) break; if (_sp > XB_SPIN_CAP) { atomicAdd(&(bar)[XB_TMO], 1u); break; } } } } while (0)

struct XcdBarrier {
    unsigned* bar; unsigned x;
    volatile LAS unsigned* st;
};

__device__ __forceinline__ XcdBarrier xcd_barrier_post(unsigned* bar, volatile LAS unsigned* st) {
    XcdBarrier b; b.bar = bar; b.x = xb_xcc_id(); b.st = st;
    if (threadIdx.x == 0) (void)xb_add(&bar[XB_XCNT(b.x)], 1u);
    return b;
}
__device__ __forceinline__ void xcd_barrier_complete(unsigned* bar, unsigned x, unsigned& nloc, unsigned& nx) {
    const unsigned G = gridDim.x * gridDim.y * gridDim.z;
    unsigned sum, cnt, mine, sp = 0u;
    for (;;) {
        sum = 0u; cnt = 0u; mine = 0u;
#pragma unroll
        for (unsigned j = 0; j < 16; ++j) { const unsigned c = xb_ld(&bar[XB_XCNT(j)]); sum += c; cnt += (c > 0u) ? 1u : 0u; mine = (j == x) ? c : mine; }
        if (sum == G) break;
        __builtin_amdgcn_s_sleep(1);
        if ((++sp & 255u) == 0u) { if (xb_ld(&bar[XB_TMO])) break; if (sp > XB_SPIN_CAP) { atomicAdd(&bar[XB_TMO], 1u); break; } }
    }
    nloc = mine > 0u ? mine : 1u; nx = cnt > 0u ? cnt : 1u;
}

__device__ __forceinline__ void xcd_barrier(const XcdBarrier& b) {
    asm volatile("s_waitcnt vmcnt(0)" ::: "memory");
    __syncthreads();
    if (threadIdx.x == 0) {
        unsigned* bar = b.bar;
        __builtin_amdgcn_s_waitcnt(0);
        unsigned nloc = b.st[0], nx = b.st[1];
        if (nloc == 0u) { xcd_barrier_complete(bar, b.x, nloc, nx); b.st[0] = nloc; b.st[1] = nx; }
        const unsigned mygen = b.st[2];
        const unsigned old = xb_add(&bar[XB_XSUB(b.x)], 1u);
        const unsigned gen = old / nloc;
        if (old + 1u == (gen + 1u) * nloc) {
            __builtin_amdgcn_fence(__ATOMIC_RELEASE, "agent");
            asm volatile("s_waitcnt vmcnt(0)" ::: "memory");
            const unsigned og = xb_add(&bar[XB_TOP], 1u);
            const unsigned tg = og / nx;
            if (og + 1u == (tg + 1u) * nx) xb_add(&bar[XB_TOPGEN], 1u);
        }
        XB_SPIN(xb_ld(&bar[XB_TOPGEN]) == mygen, bar);
        __builtin_amdgcn_fence(__ATOMIC_ACQUIRE, "agent");
        asm volatile("s_waitcnt vmcnt(0)" ::: "memory");
        b.st[2] = mygen + 1u;
    }
    __syncthreads();
}


__device__ __forceinline__ const bf16_t* da_src(const bf16_t* Z, int item, int ch) {
    const int sub = item & 31, hd = (item >> 5) & 3, gi = (item >> 7) % 3, b = item / 384;
    const int dl = gi == 0 ? 0 : (gi == 1 ? 2 : 4);
    const int d = 1 << dl, L = SEQ >> dl;
    const int r = sub & (d - 1), n = sub >> dl;
    const int row = ch >> 4, c16 = ch & 15;
    int lk = 128 * n - 128 + row; lk = lk < 0 ? 0 : (lk > L - 1 ? L - 1 : lk);
    return Z + ((size_t)b * SEQ + (size_t)lk * d + r) * ZA_W + gi * 512 + hd * 128 + c16 * 8;
}


struct Sched3 {
    pg8::StaticOrder S; const unsigned char* ws; const unsigned char* outp; int nk;
    __device__ bool next(int i, pg8::Unit& u) const { if (i >= nk) return false; if (!S.next(0, u)) return false; u.kind = i; return true; }
    __device__ __forceinline__ void a_ready(const pg8::Unit&) const {}
    __device__ __forceinline__ void done(const pg8::Unit&) const {}
    __device__ __forceinline__ const char* baseA(const pg8::Gemm&, const pg8::Unit& u) const { const long long dlt = (long long)(outp + 32 * MiB) - (long long)(ws + WS_H); return (const char*)(ws + WS_H) + (long long)(u.kind >> 1) * dlt; }
    __device__ __forceinline__ const char* baseB(const pg8::Gemm&, const pg8::Unit& u) const { return (const char*)(ws + WS_WIN + (size_t)7680 * DM * 2 + (size_t)u.kind * ((size_t)1024 * DM * 2)); }
};

struct Args {
    const float* x; const float* p; const float* w_in; const float* b_gate; const float* g_mix; const float* q_gain; const float* k_gain; const float* ret_gn;
    const float* w_ret_out; const float* w_att_out; const float* w_o; const float* g_mlp; const float* w_up; const float* w_down; const float* g_ple;
    const float* w_ple_proj; const float* w_ple_gate;
    float* out; unsigned char* ws; int ph_lo, ph_hi, li, dry8;
};

__device__ __forceinline__ u32x4 widen_pair(u32x2 a, u32x2 b) {
    const auto s0 = __builtin_amdgcn_permlane16_swap(a.x, b.x, false, false);
    const auto s1 = __builtin_amdgcn_permlane16_swap(a.y, b.y, false, false);
    u32x4 v; v.x = s0[0]; v.y = s1[0]; v.z = s0[1]; v.w = s1[1]; return v;
}
__device__ __forceinline__ float wave_sum(float v) {
#pragma unroll
    for (int o = 1; o < 64; o <<= 1) v += __shfl_xor(v, o);
    return v;
}

__device__ __forceinline__ int head_perm_row(int n) {
    const bool rot = (n < 1024) || (n >= 3072 && n < 6144);
    if (!rot) return n;
    const int j = n & 127, jj = j & 63;
    return (n & ~127) + 8 * (jj >> 2) + (jj & 3) + (j >= 64 ? 4 : 0);
}
template <bool HPERM>
__device__ __forceinline__ void p0_transpose_item(const float* W, int K, int N, bf16_t* WT, LAS float* scr, int item, int lane) {
    const int nblk = N / 32, kb = item / nblk, nb = item % nblk, k0 = 64 * kb, n0 = 32 * nb;
    { f32x4 t[8];
#pragma unroll
      for (int i = 0; i < 8; ++i) t[i] = *(const f32x4*)(W + (size_t)(k0 + 8 * i + (lane >> 3)) * N + n0 + 4 * (lane & 7));
#pragma unroll
      for (int i = 0; i < 8; ++i) { LAS float* d = scr + (8 * i + (lane >> 3)) * 33 + 4 * (lane & 7); d[0] = t[i][0]; d[1] = t[i][1]; d[2] = t[i][2]; d[3] = t[i][3]; } }
    asm volatile("s_waitcnt lgkmcnt(0)" ::: "memory");
    const int c = lane & 7;
#pragma unroll
    for (int j = 0; j < 4; ++j) { const int n = (lane >> 3) + 8 * j; const LAS float* s = scr + (8 * c) * 33 + n;
        u32x4 o; o.x = pk2(s[0 * 33], s[1 * 33]); o.y = pk2(s[2 * 33], s[3 * 33]); o.z = pk2(s[4 * 33], s[5 * 33]); o.w = pk2(s[6 * 33], s[7 * 33]);
        *(u32x4*)(WT + (size_t)(HPERM ? head_perm_row(n0 + n) : (n0 + n)) * K + k0 + 8 * c) = o; }
    asm volatile("s_waitcnt lgkmcnt(0)" ::: "memory");
}

__global__ void __launch_bounds__(512, 2) fwd_kernel(Args A) {
    extern __shared__ __attribute__((aligned(16))) unsigned char lds_raw[];
    LAS unsigned char* lds = (LAS unsigned char*)lds_raw;
    const int tid = threadIdx.x, lane = tid & 63, wave = __builtin_amdgcn_readfirstlane(tid >> 6);
    const int G = gridDim.x, bid = blockIdx.x;
    const int gw = bid * 8 + wave, NGW = G * 8;
    const int lo = A.ph_lo, hi = A.ph_hi;
    unsigned char* ws = A.ws;
    bf16_t* WinT = (bf16_t*)(ws + WS_WIN); bf16_t* WretT = (bf16_t*)(ws + WS_WRET); bf16_t* WattT = (bf16_t*)(ws + WS_WATT); bf16_t* WoT = (bf16_t*)(ws + WS_WO);
    bf16_t* WupT = (bf16_t*)(ws + WS_WUP); bf16_t* WdnT = (bf16_t*)(ws + WS_WDN); bf16_t* WpgT = (bf16_t*)(ws + WS_WPG); bf16_t* WppT = (bf16_t*)(ws + WS_WPP);
    bf16_t* PBF = (bf16_t*)(ws + WS_PBF); bf16_t* HB = (bf16_t*)(ws + WS_H); bf16_t* Z = (bf16_t*)(ws + WS_Z); bf16_t* PREV = (bf16_t*)(ws + WS_PREV);
    bf16_t* MERGED = (bf16_t*)(ws + WS_MERGED); bf16_t* PPB = (bf16_t*)(ws + WS_PP);
    float* LSE = (float*)(ws + WS_LSE); float* SSQ1 = (float*)(ws + WS_SSQ1); float* SSQ2 = (float*)(ws + WS_SSQ2);
    bf16_t* KV = (bf16_t*)A.out;
    bf16_t* OATT = (bf16_t*)A.out;
    bf16_t* YG = (bf16_t*)((unsigned char*)A.out + 32 * MiB);
    cg::grid_group grid = cg::this_grid();
#define IN(k) (lo <= (k) && (k) < hi)
#define SEAM(k) do { if (IN(k) && IN((k) + 1)) xcd_barrier(bar); } while (0)
    volatile LAS unsigned* bst = (volatile LAS unsigned*)(lds + (LDS_BYTES - 64));
    if (tid == 0) { bst[0] = 0u; bst[1] = 0u; bst[2] = 0u; }
    __syncthreads();
    XcdBarrier bar = xcd_barrier_post((unsigned*)(ws + WS_BAR + (size_t)A.li * BAR_STRIDE), bst);
    if (lo > hi) grid.sync();

    if (IN(0)) {
        LAS float* scr = (LAS float*)(lds + wave * 16384);
        constexpr int I_IN = (DM / 64) * (DIN / 32), I_RET = (1024 / 64) * (DM / 32), I_ATT = (512 / 64) * (DM / 32), I_O = (DM / 64) * (DM / 32), I_UP = (DM / 64) * (DFF / 32),
                      I_DN = (DFF / 64) * (DM / 32), I_PG = (DM / 64) * (DM / 32), I_PP = (PLE / 64) * (DM / 32);
        for (int it = gw; it < I_IN; it += NGW) p0_transpose_item<true>(A.w_in, DM, DIN, WinT, scr, it, lane);
        for (int m = gw; m < MTOK; m += NGW) {
            const f32x4* xr = (const f32x4*)(A.x + (size_t)m * DM) + 2 * lane;
            const f32x4* gr = (const f32x4*)A.g_mix + 2 * lane;
            f32x4 v[4]; float s = 0.f;
#pragma unroll
            for (int j = 0; j < 2; ++j) { v[2 * j] = xr[128 * j]; v[2 * j + 1] = xr[128 * j + 1]; }
#pragma unroll
            for (int j = 0; j < 4; ++j) s += (v[j][0] * v[j][0] + v[j][1] * v[j][1]) + (v[j][2] * v[j][2] + v[j][3] * v[j][3]);
            const float rstd = rsqrtf(wave_sum(s) * (1.f / DM) + EPSN);
            u32x4* o16 = (u32x4*)(HB + (size_t)m * DM) + lane;
#pragma unroll
            for (int j = 0; j < 2; ++j) { const f32x4 g0 = gr[128 * j], g1 = gr[128 * j + 1]; const f32x4 a = v[2 * j], b = v[2 * j + 1]; u32x4 w;
                w.x = pk2(a[0] * rstd * g0[0], a[1] * rstd * g0[1]); w.y = pk2(a[2] * rstd * g0[2], a[3] * rstd * g0[3]);
                w.z = pk2(b[0] * rstd * g1[0], b[1] * rstd * g1[1]); w.w = pk2(b[2] * rstd * g1[2], b[3] * rstd * g1[3]); o16[64 * j] = w; }
        }
    }
    SEAM(0);
#ifdef XBAR
    for (int i = 0; i < XBAR; ++i) xcd_barrier(bar);
#endif

    if (IN(1)) {
        pg8::Gemm g{HB, WinT, MTOK, ZR_W, DM}; pg8::StaticOrder S; S.init(MTOK, ZR_W, G, bid, 4);
        EpiHead E{}; E.O = Z; E.ldc = ZR_W; E.nrot = 4; E.sc_lo = 2; E.sc_hi = 4; E.norm = 0; E.fdiv = 63.f; E.X = (LAS float*)(lds + 131072);
        pg8::gemm_phase<EpiHead, pg8::StaticOrder, true, true>(lds, g, S, E);
    }
    SEAM(1);

    if (IN(3)) {
        LAS unsigned char* Ks = lds; LAS unsigned char* Vs = lds + 36864;
        const int g4 = lane >> 4, qq = (lane & 15) >> 2, pp = lane & 3;
        for (int item = bid; item < 512; item += G) {
            const int b = item >> 7, h = (item >> 5) & 3, n = item & 31;
            const size_t tok0 = (size_t)b * SEQ + n * 128;
            const float lg2 = ret_lg2(h);
            __syncthreads();
            for (int ch = tid; ch < 128 * 16; ch += 512) {
                const int row = ch >> 4, c16 = ch & 15;
                const u32x4 v = *(const u32x4*)(Z + (tok0 + row) * ZR_W + 512 + h * 128 + c16 * 8);
                const float dec = exp2f(lg2 * (float)(127 - row));
                u32x4 w; w.x = pk2(lo16(v.x) * dec, hi16(v.x) * dec); w.y = pk2(lo16(v.y) * dec, hi16(v.y) * dec); w.z = pk2(lo16(v.z) * dec, hi16(v.z) * dec); w.w = pk2(lo16(v.w) * dec, hi16(v.w) * dec);
                *(LAS u32x4*)(Ks + row * 288 + c16 * 16) = w;
            }
            for (int ch = tid; ch < 128 * 32; ch += 512) {
                const int row = ch >> 5, c32 = ch & 31;
                *(LAS u32x4*)(Vs + row * 544 + c32 * 16) = *(const u32x4*)(Z + (tok0 + row) * ZR_W + 1024 + h * 256 + c32 * 8);
            }
            __syncthreads();
            bf16x8 af[4];
#pragma unroll
            for (int s = 0; s < 4; ++s) { const LAS unsigned char* kb = Ks + (32 * s + 8 * g4 + qq) * 288 + (16 * wave + 4 * pp) * 2; af[s] = cat8(tr4(kb), tr4(kb + 4 * 288)); }
            bf16_t* kvo = KV + (size_t)item * 32768 + (size_t)(lane & 15) * 128 + 16 * wave + 4 * g4;
#pragma unroll 2
            for (int c = 0; c < 16; c += 2) {
                f32x4 a = {0.f, 0.f, 0.f, 0.f}, a2 = {0.f, 0.f, 0.f, 0.f};
#pragma unroll
                for (int s = 0; s < 4; ++s) { const LAS unsigned char* vb = Vs + (32 * s + 8 * g4 + qq) * 544 + (16 * c + 4 * pp) * 2;
                    a = mfma16(af[s], cat8(tr4(vb), tr4(vb + 4 * 544)), a); a2 = mfma16(af[s], cat8(tr4(vb + 32), tr4(vb + 32 + 4 * 544)), a2); }
                u32x2 wa, wb; wa.x = pk2(a[0], a[1]); wa.y = pk2(a[2], a[3]); wb.x = pk2(a2[0], a2[1]); wb.y = pk2(a2[2], a2[3]);
                *(u32x4*)(kvo + (size_t)(c + (g4 & 1)) * 16 * 128 - ((g4 & 1) ? 4 : 0)) = widen_pair(wa, wb);
            }
        }
    }
    SEAM(3);

    if (IN(4)) {
        for (int idx = bid * 512 + tid; idx < 16 * 8192; idx += G * 512) {
            const int bh = idx >> 13, rem = idx & 8191;
            const float cd = exp2f(ret_lg2(bh & 3) * 128.f);
            f32x4 st = {0.f, 0.f, 0.f, 0.f};
            const size_t base = (size_t)bh * 32 * 32768 + (size_t)rem * 4;
#pragma unroll 1
            for (int n0 = 0; n0 < 32; n0 += 16) {
                f32x4 kv[16];
#pragma unroll
                for (int j = 0; j < 16; ++j) { const u32x2 t = *(const u32x2*)(KV + base + (size_t)(n0 + j) * 32768); kv[j] = (f32x4){lo16(t.x), hi16(t.x), lo16(t.y), hi16(t.y)}; }
#pragma unroll
                for (int j = 0; j < 16; ++j) {
                    u32x2 w; w.x = pk2(st[0], st[1]); w.y = pk2(st[2], st[3]);
                    *(u32x2*)(PREV + base + (size_t)(n0 + j) * 32768) = w;
                    st = st * cd + kv[j];
                }
            }
        }
    }
    SEAM(4);

    if (IN(5)) {
        LAS unsigned char* Vs = lds; LAS unsigned char* Ps = lds + 69632;
        const int g4 = lane >> 4, qi = lane & 15, qq = (lane & 15) >> 2, pp = lane & 3;
        for (int item = bid; item < 512; item += G) {
            const int b = item >> 7, h = (item >> 5) & 3, n = item & 31;
            const size_t tok0 = (size_t)b * SEQ + n * 128;
            const float lg2 = ret_lg2(h);
            u32x4 sv[8], sp_[8];
#pragma unroll
            for (int i = 0; i < 8; ++i) { const int ch = tid + 512 * i; sv[i] = *(const u32x4*)(Z + (tok0 + (ch >> 5)) * ZR_W + 1024 + h * 256 + (ch & 31) * 8); }
#pragma unroll
            for (int i = 0; i < 8; ++i) { const int ch = tid + 512 * i; sp_[i] = *(const u32x4*)(PREV + (size_t)item * 32768 + (ch >> 4) * 128 + (ch & 15) * 8); }
            const int iq = 16 * wave + qi;
            const size_t tokq = tok0 + iq;
            bf16x8 qf[4];
#pragma unroll
            for (int kk = 0; kk < 4; ++kk) qf[kk] = *(const bf16x8*)(Z + tokq * ZR_W + h * 128 + 32 * kk + 8 * g4);
            bf16x8 pf[4];
            {
                f32x4 st[8];
#pragma unroll
                for (int kt = 0; kt < 8; ++kt) {
                    f32x4 a = {0.f, 0.f, 0.f, 0.f};
                    if (kt <= wave) {
                        const bf16_t* kp = Z + (tok0 + 16 * kt + qi) * ZR_W + 512 + h * 128 + 8 * g4;
#pragma unroll
                        for (int kk = 0; kk < 4; ++kk) a = mfma16(*(const bf16x8*)(kp + 32 * kk), qf[kk], a);
#pragma unroll
                        for (int e = 0; e < 4; ++e) { const int diff = iq - (16 * kt + 4 * g4 + e); a[e] = diff >= 0 ? a[e] * __builtin_amdgcn_exp2f(lg2 * (float)diff) : 0.f; }
                    }
                    st[kt] = a;
                }
#pragma unroll
                for (int s = 0; s < 4; ++s) { u32x4 w; w.x = pk2(st[2 * s][0], st[2 * s][1]); w.y = pk2(st[2 * s][2], st[2 * s][3]); w.z = pk2(st[2 * s + 1][0], st[2 * s + 1][1]); w.w = pk2(st[2 * s + 1][2], st[2 * s + 1][3]); pf[s] = __builtin_bit_cast(bf16x8, w); }
            }
            __syncthreads();
#pragma unroll
            for (int i = 0; i < 8; ++i) { const int ch = tid + 512 * i; *(LAS u32x4*)(Vs + (ch >> 5) * 544 + (ch & 31) * 16) = sv[i]; }
#pragma unroll
            for (int i = 0; i < 8; ++i) { const int ch = tid + 512 * i; *(LAS u32x4*)(Ps + (ch >> 4) * 272 + (ch & 15) * 16) = sp_[i]; }
            __syncthreads();
            f32x4 acc[16];
            const LAS unsigned char* pv = Ps + qi * 272 + 16 * g4;
#pragma unroll
            for (int c = 0; c < 16; ++c) {
                f32x4 a = {0.f, 0.f, 0.f, 0.f};
#pragma unroll
                for (int kk = 0; kk < 4; ++kk) a = mfma16(*(const LAS bf16x8*)(pv + c * 16 * 272 + 64 * kk), qf[kk], a);
                acc[c] = a;
            }
            const float qd = exp2f(lg2 * (float)(iq + 1));
#pragma unroll
            for (int c = 0; c < 16; ++c) acc[c] = acc[c] * qd;
#pragma unroll
            for (int s = 0; s < 4; ++s) {
                if (2 * s <= wave) {
                    const LAS unsigned char* vb = Vs + (32 * s + 4 * g4 + qq) * 544 + pp * 8;
#pragma unroll
                    for (int c = 0; c < 16; ++c) acc[c] = mfma16(cat8(tr4(vb + c * 32), tr4(vb + 16 * 544 + c * 32)), pf[s], acc[c]);
                }
            }
            float ssq = 0.f;
#pragma unroll
            for (int c = 0; c < 16; ++c) ssq += (acc[c][0] * acc[c][0] + acc[c][1] * acc[c][1]) + (acc[c][2] * acc[c][2] + acc[c][3] * acc[c][3]);
            ssq += __shfl_xor(ssq, 16); ssq += __shfl_xor(ssq, 32);
            const float rstd = rsqrtf(ssq * (1.f / 256.f) + EPSN);
            const bf16_t* rgp = Z + tokq * ZR_W + 2048 + h * 256 + 4 * g4;
            const float* gnp = A.ret_gn + h * 256 + 4 * g4;
            bf16_t* yo = YG + tokq * 1024 + h * 256 + 4 * g4;
#pragma unroll
            for (int cb = 0; cb < 2; ++cb) {
                u32x2 rgv[8]; f32x4 gnv[8];
#pragma unroll
                for (int c8 = 0; c8 < 8; ++c8) { rgv[c8] = *(const u32x2*)(rgp + 16 * (8 * cb + c8)); gnv[c8] = *(const f32x4*)(gnp + 16 * (8 * cb + c8)); }
#pragma unroll
                for (int c8 = 0; c8 < 8; c8 += 2) {
                    u32x2 wp[2];
#pragma unroll
                    for (int t2 = 0; t2 < 2; ++t2) {
                        const int c = 8 * cb + c8 + t2;
                        const u32x2 rg = rgv[c8 + t2];
                        const f32x4 gn = gnv[c8 + t2];
                        const float r0 = lo16(rg.x), r1 = hi16(rg.x), r2 = lo16(rg.y), r3 = hi16(rg.y);
                        wp[t2].x = pk2(r0 * sigmoidf_(r0) * (acc[c][0] * rstd * gn[0]), r1 * sigmoidf_(r1) * (acc[c][1] * rstd * gn[1]));
                        wp[t2].y = pk2(r2 * sigmoidf_(r2) * (acc[c][2] * rstd * gn[2]), r3 * sigmoidf_(r3) * (acc[c][3] * rstd * gn[3]));
                    }
                    *(u32x4*)(yo + 16 * (8 * cb + c8) + ((g4 & 1) ? 12 : 0)) = widen_pair(wp[0], wp[1]);
                }
            }
        }
    }
    SEAM(5);

    if (IN(6)) {
        pg8::Gemm g{HB, WinT + (size_t)3072 * DM, MTOK, ZA_W, DM}; pg8::StaticOrder S; S.init(MTOK, ZA_W, G, bid, 4);
        EpiHead E{}; E.O = Z; E.ldc = ZA_W; E.nrot = 12; E.sc_lo = 0; E.sc_hi = 6; E.norm = 1; E.qgain = A.q_gain; E.kgain = A.k_gain; E.fdiv = 64.f; E.X = (LAS float*)(lds + 131072);
        pg8::gemm_phase<EpiHead, pg8::StaticOrder, true, true>(lds, g, S, E);
        if (bid >= G / 2) {
            __syncthreads();
            LAS float* scr = (LAS float*)(lds + wave * 16384);
            constexpr int I_RET = (1024 / 64) * (DM / 32), I_ATT = (512 / 64) * (DM / 32), I_O = (DM / 64) * (DM / 32), I_UP = (DM / 64) * (DFF / 32),
                          I_DN = (DFF / 64) * (DM / 32), I_PG = (DM / 64) * (DM / 32), I_PP = (PLE / 64) * (DM / 32);
            constexpr int NITEMS = I_RET + I_ATT + I_O + I_UP + I_DN + I_PG + I_PP;
            for (int it = (bid - G / 2) * 8 + wave; it < NITEMS; it += (G / 2) * 8) {
                int r = it;
                if (r < I_RET) { p0_transpose_item<false>(A.w_ret_out, 1024, DM, WretT, scr, r, lane); continue; } r -= I_RET;
                if (r < I_ATT) { p0_transpose_item<false>(A.w_att_out, 512, DM, WattT, scr, r, lane); continue; } r -= I_ATT;
                if (r < I_O) { p0_transpose_item<false>(A.w_o, DM, DM, WoT, scr, r, lane); continue; } r -= I_O;
                if (r < I_UP) { p0_transpose_item<false>(A.w_up, DM, DFF, WupT, scr, r, lane); continue; } r -= I_UP;
                if (r < I_DN) { p0_transpose_item<false>(A.w_down, DFF, DM, WdnT, scr, r, lane); continue; } r -= I_DN;
                if (r < I_PG) { p0_transpose_item<false>(A.w_ple_gate, DM, DM, WpgT, scr, r, lane); continue; } r -= I_PG;
                p0_transpose_item<false>(A.w_ple_proj, PLE, DM, WppT, scr, r, lane);
            }
        for (size_t i = (size_t)(bid - G / 2) * 512 + tid; i < (size_t)MTOK * PLE / 8; i += (size_t)(G / 2) * 512) {
            const f32x4 a = ((const f32x4*)A.p)[2 * i], b = ((const f32x4*)A.p)[2 * i + 1];
            u32x4 w; w.x = pk2(a[0], a[1]); w.y = pk2(a[2], a[3]); w.z = pk2(b[0], b[1]); w.w = pk2(b[2], b[3]);
            ((u32x4*)PBF)[i] = w;
        }
        }
    }
    SEAM(6);

    if (IN(8)) {
        LAS unsigned char* Vs = lds; LAS unsigned char* Ks = lds + 78336;
        const int g4 = lane >> 4, qi = lane & 15, qq = (lane & 15) >> 2, pp = lane & 3;
        const int vcu = (G & 7) == 0 ? (bid & 7) * (G >> 3) + (bid >> 3) : bid;
        u32x4 kr[8], vr[8];
        for (int i = tid; i < 16 * 18; i += 512) *(LAS u32x4*)(Vs + 256 * 288 + i * 16) = (u32x4){0u, 0u, 0u, 0u};
        for (int i = tid; i < 16 * 17; i += 512) *(LAS u32x4*)(Ks + 256 * 272 + i * 16) = (u32x4){0u, 0u, 0u, 0u};
        if (vcu < 1536) {
#pragma unroll
            for (int i = 0; i < 8; ++i) { const int ch = tid + 512 * i; { const bf16_t* src = da_src(Z, vcu, ch); vr[i] = *(const u32x4*)(src + 3072); kr[i] = *(const u32x4*)(src + 1536); } }
        }
        for (int item = vcu; item < 1536; item += G) {
            const int sub = item & 31, hd = (item >> 5) & 3, gi = (item >> 7) % 3, b = item / 384;
            const int dl = gi == 0 ? 0 : (gi == 1 ? 2 : 4);
            const int d = 1 << dl;
            const int r = sub & (d - 1), n = sub >> dl;
            const size_t tb = (size_t)b * SEQ;
            const int lq = 128 * n + 16 * wave + qi;
            const size_t tq = tb + (size_t)lq * d + r;
            bf16_t* qp = Z + tq * ZA_W + gi * 512 + hd * 128;
            bf16x8 qf[4];
#pragma unroll
            for (int kk = 0; kk < 4; ++kk) qf[kk] = *(const bf16x8*)(qp + 32 * kk + 8 * g4);
            __syncthreads();
#pragma unroll
            for (int i = 0; i < 8; ++i) { const int ch = tid + 512 * i; { const int row = ch >> 4, c16 = ch & 15;
                *(LAS u32x4*)(Vs + row * 288 + c16 * 16) = vr[i]; *(LAS u32x4*)(Ks + row * 272 + c16 * 16) = kr[i]; } }
            __syncthreads();
            if (item + G < 1536) {
#pragma unroll
                for (int i = 0; i < 8; ++i) { const int ch = tid + 512 * i; { const bf16_t* src = da_src(Z, item + G, ch); vr[i] = *(const u32x4*)(src + 3072); kr[i] = *(const u32x4*)(src + 1536); } }
            }
            f32x4 st[10];
            const int lk0 = 128 * n + 16 * wave - 128;
#pragma unroll
            for (int kt = 0; kt < 10; ++kt) {
                const LAS unsigned char* kp = Ks + (16 * wave + 16 * kt + qi) * 272 + 16 * g4;
                f32x4 a = {0.f, 0.f, 0.f, 0.f};
#pragma unroll
                for (int kk = 0; kk < 4; ++kk) a = mfma16(*(const LAS bf16x8*)(kp + 64 * kk), qf[kk], a);
                st[kt] = a;
            }
            float mx = -1e30f;
#pragma unroll
            for (int kt = 0; kt < 10; ++kt)
#pragma unroll
                for (int e = 0; e < 4; ++e) {
                    const int dist = 128 + qi - 16 * kt - 4 * g4 - e;
                    const int lkk = lk0 + 16 * kt + 4 * g4 + e;
                    const bool ok = dist >= 0 && dist <= 128 && lkk >= 0;
                    const float sv = ok ? st[kt][e] : -1e30f;
                    st[kt][e] = sv; mx = fmaxf(mx, sv);
                }
            mx = fmaxf(mx, __shfl_xor(mx, 16)); mx = fmaxf(mx, __shfl_xor(mx, 32));
            float sum = 0.f;
#pragma unroll
            for (int kt = 0; kt < 10; ++kt)
#pragma unroll
                for (int e = 0; e < 4; ++e) { const float pe = __builtin_amdgcn_exp2f((st[kt][e] - mx) * LOG2E); st[kt][e] = pe; sum += pe; }
            sum += __shfl_xor(sum, 16); sum += __shfl_xor(sum, 32);
            const float inv = 1.f / sum;
            bf16x8 pf[5];
#pragma unroll
            for (int s = 0; s < 5; ++s) { u32x4 w; w.x = pk2(st[2 * s][0] * inv, st[2 * s][1] * inv); w.y = pk2(st[2 * s][2] * inv, st[2 * s][3] * inv);
                w.z = pk2(st[2 * s + 1][0] * inv, st[2 * s + 1][1] * inv); w.w = pk2(st[2 * s + 1][2] * inv, st[2 * s + 1][3] * inv); pf[s] = __builtin_bit_cast(bf16x8, w); }
            f32x4 o[8];
#pragma unroll
            for (int c = 0; c < 8; ++c) o[c] = (f32x4){0.f, 0.f, 0.f, 0.f};
#pragma unroll
            for (int s = 0; s < 5; ++s) {
                const LAS unsigned char* vb = Vs + (16 * wave + 32 * s + 4 * g4 + qq) * 288 + pp * 8;
#pragma unroll
                for (int c = 0; c < 8; ++c) o[c] = mfma16(cat8(tr4(vb + c * 32), tr4(vb + 16 * 288 + c * 32)), pf[s], o[c]);
            }
#pragma unroll
            for (int c = 0; c < 8; c += 2) { u32x2 wa, wb; wa.x = pk2(o[c][0], o[c][1]); wa.y = pk2(o[c][2], o[c][3]); wb.x = pk2(o[c + 1][0], o[c + 1][1]); wb.y = pk2(o[c + 1][2], o[c + 1][3]);
                const u32x4 wv = widen_pair(wa, wb); if (!A.dry8) *(u32x4*)(qp + 16 * c + 4 * g4 + ((g4 & 1) ? 12 : 0)) = wv; }
            if (g4 == 0 && !A.dry8) LSE[tq * 12 + gi * 4 + hd] = mx + __logf(sum);
        }
    }
    SEAM(8);

    if (IN(9)) {
        for (int idx = bid * 512 + tid; idx < MTOK * 64; idx += G * 512) {
            const int m = idx >> 6, hd = (idx >> 4) & 3, ch = idx & 15;
            const float l0 = LSE[(size_t)m * 12 + hd], l1 = LSE[(size_t)m * 12 + 4 + hd], l2 = LSE[(size_t)m * 12 + 8 + hd];
            const float mx = fmaxf(l0, fmaxf(l1, l2));
            float w0 = __expf(l0 - mx), w1 = __expf(l1 - mx), w2 = __expf(l2 - mx);
            const float inv = 1.f / (w0 + w1 + w2); w0 *= inv; w1 *= inv; w2 *= inv;
            const bf16_t* zp = Z + (size_t)m * ZA_W + hd * 128 + ch * 8;
            const u32x4 a = *(const u32x4*)zp, b2 = *(const u32x4*)(zp + 512), c2 = *(const u32x4*)(zp + 1024);
            u32x4 w;
            w.x = pk2(w0 * lo16(a.x) + w1 * lo16(b2.x) + w2 * lo16(c2.x), w0 * hi16(a.x) + w1 * hi16(b2.x) + w2 * hi16(c2.x));
            w.y = pk2(w0 * lo16(a.y) + w1 * lo16(b2.y) + w2 * lo16(c2.y), w0 * hi16(a.y) + w1 * hi16(b2.y) + w2 * hi16(c2.y));
            w.z = pk2(w0 * lo16(a.z) + w1 * lo16(b2.z) + w2 * lo16(c2.z), w0 * hi16(a.z) + w1 * hi16(b2.z) + w2 * hi16(c2.z));
            w.w = pk2(w0 * lo16(a.w) + w1 * lo16(b2.w) + w2 * lo16(c2.w), w0 * hi16(a.w) + w1 * hi16(b2.w) + w2 * hi16(c2.w));
            *(u32x4*)(OATT + (size_t)m * 512 + hd * 128 + ch * 8) = w;
        }
    }
    SEAM(9);

    if (IN(11)) {
        bf16_t* SCR = Z + (size_t)bid * 131072;
        {
            pg8::Gemm g{HB, WinT, MTOK, DM, DM};
            Sched3 S3; S3.S.init(MTOK, DM, G, bid); S3.ws = ws; S3.outp = (const unsigned char*)A.out; S3.nk = lo < 0 ? 2 : 3;
            Epi<6> E{}; E.O = MERGED; E.ldc = DM; E.SCR = SCR; E.bias = A.b_gate;
            pg8::gemm_phase<Epi<6>, Sched3, true, true>(lds, g, S3, E);
        }
        __syncthreads();
        {
            pg8::Gemm g{OATT, WattT, MTOK, DM, 512}; pg8::StaticOrder S; S.init(MTOK, DM, G, bid);
            Epi<3> E{}; E.O = MERGED; E.ldc = DM; E.SCR = SCR;
            pg8::gemm_phase<Epi<3>, pg8::StaticOrder, true, true>(lds, g, S, E);
        }
    }
    SEAM(11);

    if (IN(12)) {
        pg8::Gemm g{MERGED, WoT, MTOK, DM, DM}; pg8::StaticOrder S; S.init(MTOK, DM, G, bid);
        Epi<4> E{}; E.O = HB; E.ldc = DM; E.Xin = A.x; E.Xout = A.out; E.gvec = A.g_mlp; E.Pout = SSQ1;
        pg8::gemm_phase<Epi<4>, pg8::StaticOrder, true, true>(lds, g, S, E);
        __syncthreads();
        {
            pg8::Gemm g2{PBF, WppT, MTOK, DM, lo < 0 ? 512 : PLE};     pg8::StaticOrder S2; S2.init(MTOK, DM, G, bid);
            Epi<0> E2{}; E2.O = PPB; E2.ldc = DM;
            pg8::gemm_phase<Epi<0>, pg8::StaticOrder, true, true>(lds, g2, S2, E2);
        }
    }
    SEAM(12);

    if (IN(13)) {
        pg8::Gemm g{HB, WupT, MTOK, DFF, DM}; pg8::StaticOrder S; S.init(MTOK, DFF, G, bid, 4);
        Epi<5> E{}; E.O = Z; E.ldc = DFF; E.Pin = SSQ1;
        pg8::gemm_phase<Epi<5>, pg8::StaticOrder, true, true>(lds, g, S, E);
    }
    SEAM(13);

    if (IN(14)) {
        {
            pg8::Gemm g{Z, WdnT, MTOK, DM, DFF}; pg8::StaticOrder S; S.init(MTOK, DM, G, bid);
            Epi<4> E{}; E.O = HB; E.ldc = DM; E.Xin = A.out; E.Xout = A.out; E.gvec = A.g_ple; E.Pout = SSQ2;
            pg8::gemm_phase<Epi<4>, pg8::StaticOrder, true, true>(lds, g, S, E);
        }
    }
    SEAM(14);

    if (IN(15)) {
        pg8::Gemm g{HB, WpgT, MTOK, DM, DM}; pg8::StaticOrder S; S.init(MTOK, DM, G, bid);
        Epi<7> E{}; E.Xin = A.out; E.Xout = A.out; E.Pin = SSQ2; E.PP = PPB;
        pg8::gemm_phase<Epi<7>, pg8::StaticOrder, true, true>(lds, g, S, E);
    }
#undef IN
#undef SEAM
}

#ifndef N_LAUNCH_MODE
#define N_LAUNCH_MODE 1
#endif
constexpr int N_PHASES = 16;

extern "C" void kernel_launch(void* const* d_in, const int* in_sizes, int n_in, void* d_out, int out_size, void* d_ws, size_t ws_size, hipStream_t stream) {
    static int grid = 0;
    if (grid == 0) {
        int dev = 0, cus = 0, per_cu = 0;
        hipGetDevice(&dev);
        hipDeviceGetAttribute(&cus, hipDeviceAttributeMultiprocessorCount, dev);
        if (hipFuncSetAttribute((const void*)fwd_kernel, hipFuncAttributeMaxDynamicSharedMemorySize, LDS_BYTES) != hipSuccess) fprintf(stderr, "kernel_launch: hipFuncSetAttribute failed\n");
        if (hipOccupancyMaxActiveBlocksPerMultiprocessor(&per_cu, (const void*)fwd_kernel, 512, LDS_BYTES) != hipSuccess || per_cu < 1) { fprintf(stderr, "kernel_launch: occupancy query says %d\n", per_cu); per_cu = 1; }
        (void)hipGetLastError();
        grid = cus * 1;
        if (ws_size < WS_END) fprintf(stderr, "kernel_launch: workspace too small (%zu)\n", ws_size);
    }
    Args a{};
    a.x = (const float*)d_in[0]; a.p = (const float*)d_in[1]; a.w_in = (const float*)d_in[2]; a.b_gate = (const float*)d_in[3]; a.g_mix = (const float*)d_in[4];
    a.q_gain = (const float*)d_in[5]; a.k_gain = (const float*)d_in[6]; a.ret_gn = (const float*)d_in[7]; a.w_ret_out = (const float*)d_in[8]; a.w_att_out = (const float*)d_in[9];
    a.w_o = (const float*)d_in[10]; a.g_mlp = (const float*)d_in[11]; a.w_up = (const float*)d_in[12]; a.w_down = (const float*)d_in[13]; a.g_ple = (const float*)d_in[14];
    a.w_ple_proj = (const float*)d_in[15]; a.w_ple_gate = (const float*)d_in[16];
    a.out = (float*)d_out; a.ws = (unsigned char*)d_ws;
    if (hipMemsetAsync((char*)d_ws + WS_BAR, 0, BAR_STRIDE * BAR_MAXL, stream) != hipSuccess) fprintf(stderr, "kernel_launch: memset failed\n");
#ifdef PROBE_CUTS
    { static const int cuts[][2] = PROBE_CUTS;
      for (unsigned i = 0; i < sizeof(cuts) / sizeof(cuts[0]); ++i) {
          a.ph_lo = cuts[i][0]; a.ph_hi = cuts[i][1]; a.li = (int)i;
#ifdef PROBE_DRY8
          a.dry8 = (i == 0);
#endif
          void* args[] = {&a};
          hipError_t e = hipLaunchCooperativeKernel((const void*)fwd_kernel, dim3(grid), dim3(512), args, LDS_BYTES, stream);
          if (e != hipSuccess) fprintf(stderr, "cooperative launch failed: %s (grid %d)\n", hipGetErrorString(e), grid);
      } }
#else
    {
        a.ph_lo = 0; a.ph_hi = N_PHASES;
        void* args[] = {&a};
        hipError_t e = hipLaunchCooperativeKernel((const void*)fwd_kernel, dim3(grid), dim3(512), args, LDS_BYTES, stream);
        if (e != hipSuccess) fprintf(stderr, "cooperative launch failed: %s (grid %d)\n", hipGetErrorString(e), grid);
    }
#endif
}
```

```cpp
#include <hip/hip_runtime.h>
#include <hip/hip_cooperative_groups.h>
#include <cstdio>
#include <cstdint>
namespace cg = cooperative_groups;
namespace pg8 {
#define PG8_LAS __attribute__((address_space(3)))
typedef unsigned short bf16_t;
typedef short bf16x8 __attribute__((ext_vector_type(8)));
typedef float f32x4 __attribute__((ext_vector_type(4)));
typedef unsigned u32x4 __attribute__((ext_vector_type(4)));
constexpr int BM = 256, BK = 64, HALF = 128, HTB = HALF * BK * 2  , STAGE_BYTES = 8 * HTB, NXCD = 8, WGM = 8;

__host__ __device__ __forceinline__ int lds_byte(int r, int c) { const int st = (r >> 4) * 2 + (c >> 5), rr = r & 15, cc = c & 31, ob = rr * 64 + cc * 2; return st * 1024 + (ob ^ (((ob >> 9) & 1) << 5)); }
__host__ __device__ __forceinline__ void stage_rc(int b, int& R, int& C) { const int st = b / 1024, sb = b % 1024, swz = sb ^ (((sb >> 9) & 1) << 5); R = (st >> 1) * 16 + swz / 64; C = (st & 1) * 32 + (swz % 64) / 2; }
__host__ __device__ __forceinline__ int perm32(int rho) { const int n = rho >> 4, i = rho & 15; return 8 * (i >> 2) + 4 * n + (i & 3); }

struct Unit { int pm, pn, kind; };
struct Gemm { const bf16_t* A; const bf16_t* Bt; int M, N, K; };

struct StaticOrder {
    int nM, nN, nwg, G, c, wgm;
    __host__ __device__ void init(int M, int N, int G_, int c_, int wgm_ = 4) { nM = M / BM; nN = N / BM; nwg = nM * nN; G = G_; c = c_; wgm = wgm_; }
    __host__ __device__ bool next(int i, Unit& u) const {
        const long L = (long)i * G + c; if (L >= nwg) return false;
        int wgid = (int)L; { const int q = nwg / NXCD, r = nwg % NXCD, xcd = wgid % NXCD, off = wgid / NXCD; wgid = (xcd < r ? xcd * (q + 1) : r * (q + 1) + (xcd - r) * q) + off; }
        const int nig = wgm * nN, gid = wgid / nig, fm = gid * wgm, gsz = (nM - fm) < wgm ? (nM - fm) : wgm;
        u.pm = fm + ((wgid % nig) % gsz); u.pn = (wgid % nig) / gsz; u.kind = 0; return true;
    }
    __device__ __forceinline__ void a_ready(const Unit&) const {}
    __device__ __forceinline__ void done(const Unit&) const {}
    __device__ __forceinline__ const char* baseA(const Gemm& g, const Unit&) const { return (const char*)g.A; }
    __device__ __forceinline__ const char* baseB(const Gemm& g, const Unit&) const { return (const char*)g.Bt; }
};
__device__ __forceinline__ unsigned cvt_pk_bf16(float lo, float hi) { unsigned r; asm volatile("v_cvt_pk_bf16_f32 %0, %1, %2" : "=v"(r) : "v"(lo), "v"(hi)); return r; }
template <class Epi, class Sched, bool ALIGN_EPI = false, bool SP2 = false>
__device__ __forceinline__ void gemm_phase(PG8_LAS unsigned char* lds, const Gemm g, const Sched& S, const Epi& E) {
    const int tid = threadIdx.x, wid = __builtin_amdgcn_readfirstlane(tid >> 6), lane = tid & 63, wr = wid >> 2, wc = wid & 3, fr = lane & 15, fq = lane >> 4;
    const int K = g.K, nt = K / BK;
    unsigned voffA[2], voffB[2];
#pragma unroll
    for (int i = 0; i < 2; ++i) { int R, C; stage_rc(tid * 16 + i * 8192, R, C); const int Rb = Epi::PERM ? ((R & ~31) + perm32(R & 31)) : R;
        voffA[i] = (unsigned)(R * K + C) * 2u; voffB[i] = (unsigned)(Rb * K + C) * 2u; }
    const size_t kstep = (size_t)(BK * 2);
    const size_t hstep = (size_t)HALF * K * 2;
    const size_t tstep = 2 * hstep;
    const unsigned ldsw = (unsigned)wid * 1024u;
    const int aoff = lds_byte(wr * 64 + fr, fq * 8), boff = lds_byte(wc * 32 + fr, fq * 8);
#define PG8_SA(b, h) (((b) * 2 + (h)) * HTB)
#define PG8_SB(b, h) ((4 + (b) * 2 + (h)) * HTB)
#define PG8_STAGE(bufoff, gbase, voff) do { _Pragma("unroll") for (int _i = 0; _i < 2; ++_i) \
        __builtin_amdgcn_global_load_lds((const unsigned*)((const char*)(gbase) + (voff)[_i]), (PG8_LAS unsigned*)(lds + (bufoff) + ldsw + _i * 8192), 16, 0, 0); } while (0)
#define PG8_LDA(dst, b, h) do { _Pragma("unroll") for (int m = 0; m < 4; ++m) _Pragma("unroll") for (int k = 0; k < 2; ++k) dst[m][k] = *(const PG8_LAS bf16x8*)(lds + PG8_SA(b, h) + aoff + m * 2048 + k * 1024); } while (0)
#define PG8_LDB(dst, b, h) do { _Pragma("unroll") for (int n = 0; n < 2; ++n) _Pragma("unroll") for (int k = 0; k < 2; ++k) dst[n][k] = *(const PG8_LAS bf16x8*)(lds + PG8_SB(b, h) + boff + n * 2048 + k * 1024); } while (0)
#define PG8_MMA(ai, bj, At, Bt) do { __builtin_amdgcn_s_setprio(1); _Pragma("unroll") for (int m = 0; m < 4; ++m) _Pragma("unroll") for (int n = 0; n < 2; ++n) _Pragma("unroll") for (int k = 0; k < 2; ++k) \
        acc[ai][bj][m][n] = __builtin_amdgcn_mfma_f32_16x16x32_bf16(Bt[n][k], At[m][k], acc[ai][bj][m][n], 0, 0, 0); __builtin_amdgcn_s_setprio(0); } while (0)
#define PG8_WAIT_V(n) asm volatile("s_waitcnt vmcnt(" #n ")" ::: "memory")
#define PG8_WAIT_L(n) asm volatile("s_waitcnt lgkmcnt(" #n ")" ::: "memory")
#define PG8_BAR __builtin_amdgcn_s_barrier()
#define PG8_SCHED __builtin_amdgcn_sched_barrier(0)
    Unit cur, nxt; int ui = 0;
    if (!S.next(0, cur)) return;
    f32x4 acc[2][2][4][2];
    E.init(acc, cur, wr, wc, fr, fq);
    bf16x8 At[4][2], B0[2][2], B1[2][2];
    const char* cA = S.baseA(g, cur) + (size_t)cur.pm * tstep; const char* cB = S.baseB(g, cur) + (size_t)cur.pn * tstep;
    S.a_ready(cur);
    if constexpr (SP2) {
        PG8_STAGE(PG8_SB(0, 0), cB, voffB); PG8_STAGE(PG8_SB(0, 1), cB + hstep, voffB); PG8_STAGE(PG8_SA(0, 0), cA, voffA); PG8_STAGE(PG8_SA(0, 1), cA + hstep, voffA);
        if (wr == 1) PG8_BAR;
        PG8_WAIT_V(2); PG8_BAR;
        PG8_STAGE(PG8_SB(1, 0), cB + kstep, voffB); PG8_STAGE(PG8_SA(1, 0), cA + kstep, voffA); PG8_STAGE(PG8_SB(1, 1), cB + hstep + kstep, voffB);
        PG8_WAIT_V(6); PG8_BAR;
    } else {
        PG8_STAGE(PG8_SB(0, 0), cB, voffB); PG8_STAGE(PG8_SA(0, 0), cA, voffA); PG8_STAGE(PG8_SB(0, 1), cB + hstep, voffB); PG8_STAGE(PG8_SA(0, 1), cA + hstep, voffA);
        if (wr == 1) PG8_BAR;
        PG8_WAIT_V(4); PG8_BAR;
        PG8_STAGE(PG8_SB(1, 0), cB + kstep, voffB); PG8_STAGE(PG8_SA(1, 0), cA + kstep, voffA); PG8_STAGE(PG8_SB(1, 1), cB + hstep + kstep, voffB);
        PG8_WAIT_V(6); PG8_BAR;
    }
    for (;;) {
        const bool has_next = S.next(ui + 1, nxt);
        const char* nA = has_next ? S.baseA(g, nxt) + (size_t)nxt.pm * tstep : cA; const char* nB = has_next ? S.baseB(g, nxt) + (size_t)nxt.pn * tstep : cB;
        for (int t = 0; t < nt; t += 2) {
            const bool last = (t == nt - 2);
            const char* a1 = cA + (size_t)(t + 1) * kstep;
            const char* a2 = last ? nA : cA + (size_t)(t + 2) * kstep; const char* b2 = last ? nB : cB + (size_t)(t + 2) * kstep;
            const char* a3 = a2 + kstep; const char* b3 = b2 + kstep;
            if (last && has_next) S.a_ready(nxt);
            if constexpr (SP2) {
            PG8_LDB(B0, 0, 0); PG8_LDB(B1, 0, 1); PG8_SCHED; PG8_LDA(At, 0, 0); PG8_STAGE(PG8_SA(1, 1), a1 + hstep, voffA);
            PG8_WAIT_V(8); PG8_WAIT_L(0); PG8_BAR; PG8_MMA(0, 0, At, B0); PG8_MMA(0, 1, At, B1); PG8_BAR; PG8_SCHED;
            PG8_LDA(At, 0, 1); PG8_STAGE(PG8_SB(0, 0), b2, voffB); PG8_STAGE(PG8_SB(0, 1), b2 + hstep, voffB); PG8_STAGE(PG8_SA(0, 0), a2, voffA);
            PG8_WAIT_V(8); PG8_WAIT_L(0); PG8_BAR; PG8_MMA(1, 0, At, B0); PG8_MMA(1, 1, At, B1); PG8_BAR; PG8_SCHED;
            PG8_LDB(B0, 1, 0); PG8_LDB(B1, 1, 1); PG8_SCHED; PG8_LDA(At, 1, 0); PG8_STAGE(PG8_SA(0, 1), a2 + hstep, voffA);
            PG8_WAIT_V(8); PG8_WAIT_L(0); PG8_BAR; PG8_MMA(0, 0, At, B0); PG8_MMA(0, 1, At, B1); PG8_BAR; PG8_SCHED;
            PG8_LDA(At, 1, 1); PG8_STAGE(PG8_SB(1, 0), b3, voffB); PG8_STAGE(PG8_SB(1, 1), b3 + hstep, voffB); PG8_STAGE(PG8_SA(1, 0), a3, voffA);
            PG8_WAIT_V(8); PG8_WAIT_L(0); PG8_BAR; PG8_MMA(1, 0, At, B0); PG8_MMA(1, 1, At, B1); PG8_BAR; PG8_SCHED;
            } else {
            PG8_LDB(B0, 0, 0); PG8_SCHED; PG8_LDA(At, 0, 0); PG8_STAGE(PG8_SA(1, 1), a1 + hstep, voffA);
            PG8_WAIT_L(8); PG8_BAR; PG8_WAIT_L(0); PG8_MMA(0, 0, At, B0); PG8_BAR; PG8_SCHED;
            PG8_LDB(B1, 0, 1); PG8_STAGE(PG8_SB(0, 0), b2, voffB);
            PG8_BAR; PG8_WAIT_L(0); PG8_MMA(0, 1, At, B1); PG8_BAR;
            PG8_LDA(At, 0, 1); PG8_STAGE(PG8_SA(0, 0), a2, voffA);
            PG8_BAR; PG8_WAIT_L(0); PG8_MMA(1, 0, At, B0); PG8_BAR; PG8_SCHED;
            PG8_STAGE(PG8_SB(0, 1), b2 + hstep, voffB);
            PG8_WAIT_V(6); PG8_BAR; PG8_MMA(1, 1, At, B1); PG8_BAR;
            PG8_LDB(B0, 1, 0); PG8_SCHED; PG8_LDA(At, 1, 0); PG8_STAGE(PG8_SA(0, 1), a2 + hstep, voffA);
            PG8_WAIT_L(8); PG8_BAR; PG8_WAIT_L(0); PG8_MMA(0, 0, At, B0); PG8_BAR; PG8_SCHED;
            PG8_LDB(B1, 1, 1); PG8_STAGE(PG8_SB(1, 0), b3, voffB);
            PG8_BAR; PG8_WAIT_L(0); PG8_MMA(0, 1, At, B1); PG8_BAR;
            PG8_LDA(At, 1, 1); PG8_STAGE(PG8_SA(1, 0), a3, voffA);
            PG8_BAR; PG8_WAIT_L(0); PG8_MMA(1, 0, At, B0); PG8_BAR; PG8_SCHED;
            PG8_STAGE(PG8_SB(1, 1), b3 + hstep, voffB);
            PG8_WAIT_V(6); PG8_BAR; PG8_MMA(1, 1, At, B1); PG8_BAR;
            }
        }
        if constexpr (ALIGN_EPI) { if (wr == 0) PG8_BAR; }
        if constexpr (!Epi::AFTER_DRAIN) { E(acc, cur, wr, wc, fr, fq); S.done(cur); }
        if (!has_next) break;
        E.init(acc, nxt, wr, wc, fr, fq);
        cur = nxt; cA = nA; cB = nB; ++ui;
        if constexpr (ALIGN_EPI) { if (wr == 1) PG8_BAR; }
    }
    PG8_WAIT_V(0);
    if constexpr (!ALIGN_EPI) { if (wr == 0) PG8_BAR; }
    PG8_BAR;
    if constexpr (Epi::AFTER_DRAIN) { E.fused(acc, cur, wr, wc, fr, fq, lds, wid, lane); S.done(cur); }
#undef PG8_SA
#undef PG8_SB
#undef PG8_STAGE
#undef PG8_LDA
#undef PG8_LDB
#undef PG8_MMA
#undef PG8_WAIT_V
#undef PG8_WAIT_L
#undef PG8_BAR
#undef PG8_SCHED
}
}

#define LAS __attribute__((address_space(3)))
typedef unsigned short bf16_t;
typedef short bf16x8 __attribute__((ext_vector_type(8)));
typedef short s16x4 __attribute__((ext_vector_type(4)));
typedef float f32x4 __attribute__((ext_vector_type(4)));
typedef unsigned u32x4 __attribute__((ext_vector_type(4)));
typedef unsigned u32x2 __attribute__((ext_vector_type(2)));

constexpr int NB = 4, SEQ = 4096, DM = 1024, MTOK = NB * SEQ, DIN = 9728, DFF = 4096, PLE = 256;
constexpr int ZR_W = 3072;
constexpr int ZA_W = 4608;
constexpr int GL_W = 2048;
constexpr float EPSN = 1e-6f;
constexpr float LOG2E = 1.4426950408889634f;
constexpr float INV2PI = 0.15915494309189535f;
constexpr float QK_SCALE = 0.08838834764831845f;
constexpr float LOG2_THETA = 13.287712379549449f;

constexpr size_t MiB = 1u << 20;
constexpr size_t WS_WIN = 0, WS_WRET = 19 * MiB, WS_WATT = 21 * MiB, WS_WO = 22 * MiB, WS_WUP = 24 * MiB, WS_WDN = 32 * MiB, WS_WPG = 40 * MiB, WS_WPP = 42 * MiB;
constexpr size_t WS_PBF = 43 * MiB;
constexpr size_t WS_H = 52 * MiB;
constexpr size_t WS_Z = 84 * MiB;
constexpr size_t WS_PREV = 180 * MiB;
constexpr size_t WS_MERGED = 148 * MiB;
constexpr size_t WS_PP = 212 * MiB;
constexpr size_t WS_LSE = 244 * MiB;
constexpr size_t WS_SSQ1 = 245 * MiB, WS_SSQ2 = 246 * MiB;
constexpr size_t WS_BAR = 247 * MiB, BAR_STRIDE = 16384, BAR_MAXL = 8;
constexpr size_t WS_END = 248 * MiB;
constexpr int LDS_BYTES = 163840;

__device__ __forceinline__ float bf2f(unsigned v) { return __builtin_bit_cast(float, v << 16); }
__device__ __forceinline__ unsigned f2bf(float f) { unsigned u = __builtin_bit_cast(unsigned, f); return (u + 0x7fffu + ((u >> 16) & 1u)) >> 16; }
typedef __bf16 bf16x2_hw __attribute__((ext_vector_type(2)));
typedef float f32x2_hw __attribute__((ext_vector_type(2)));
__device__ __forceinline__ unsigned pk2(float lo, float hi) { const f32x2_hw v = {lo, hi}; return __builtin_bit_cast(unsigned, __builtin_convertvector(v, bf16x2_hw)); }
__device__ __forceinline__ float lo16(unsigned w) { return __builtin_bit_cast(float, w << 16); }
__device__ __forceinline__ float hi16(unsigned w) { return __builtin_bit_cast(float, w & 0xffff0000u); }
__device__ __forceinline__ float sigmoidf_(float x) { return __builtin_amdgcn_rcpf(1.f + __builtin_amdgcn_exp2f(-LOG2E * x)); }
__device__ __forceinline__ float ret_lg2(int h) { return h == 0 ? -0.04580368961312479f : (h == 1 ? -0.02272007650008353f : (h == 2 ? -0.011315313227834146f : -0.005646563141142063f)); }
__device__ __forceinline__ s16x4 tr4(const LAS unsigned char* p) { return __builtin_bit_cast(s16x4, __builtin_amdgcn_ds_read_tr16_b64_v4i16((LAS s16x4*)p)); }
__device__ __forceinline__ bf16x8 cat8(s16x4 a, s16x4 b) { return __builtin_shufflevector(a, b, 0, 1, 2, 3, 4, 5, 6, 7); }
__device__ __forceinline__ f32x4 mfma16(bf16x8 a, bf16x8 b, f32x4 c) { return __builtin_amdgcn_mfma_f32_16x16x32_bf16(a, b, c, 0, 0, 0); }

template <int MODE> struct Epi {
    static constexpr bool PERM = true, AFTER_DRAIN = false;
    bf16_t* O; int ldc;
    bf16_t* SCR;
    const float* bias;
    const float* Xin; float* Xout;
    const float* gvec;
    float* Pout; const float* Pin;
    const bf16_t* PP;
    __device__ __forceinline__ void init(pg8::f32x4 (&acc)[2][2][4][2], const pg8::Unit& u, int wr, int wc, int fr, int fq) const {
        if (MODE == 4) {
            const int row0 = u.pm * 256 + wr * 64 + fr, col0 = u.pn * 256 + wc * 32 + 8 * fq;
#pragma unroll
            for (int a = 0; a < 2; ++a)
#pragma unroll
                for (int m = 0; m < 4; ++m)
#pragma unroll
                    for (int b = 0; b < 2; ++b) {
                        const float* xp = Xin + (size_t)(row0 + a * 128 + m * 16) * DM + col0 + b * 128;
                        acc[a][b][m][0] = *(const pg8::f32x4*)xp; acc[a][b][m][1] = *(const pg8::f32x4*)(xp + 4);
                    }
        } else {
#pragma unroll
            for (int a = 0; a < 2; ++a)
#pragma unroll
                for (int b = 0; b < 2; ++b)
#pragma unroll
                    for (int m = 0; m < 4; ++m)
#pragma unroll
                        for (int n = 0; n < 2; ++n) acc[a][b][m][n] = (pg8::f32x4){0.f, 0.f, 0.f, 0.f};
        }
    }
    __device__ __forceinline__ void operator()(const pg8::f32x4 (&acc)[2][2][4][2], const pg8::Unit& u, int wr, int wc, int fr, int fq) const {
        const int row0 = u.pm * 256 + wr * 64 + fr;
        const int col0 = u.pn * 256 + wc * 32 + 8 * fq;
        if (MODE == 7) {
#pragma unroll
            for (int ai = 0; ai < 2; ++ai) {
                float rsq[4];
                {
                    f32x4 t[4][4];
#pragma unroll
                    for (int m = 0; m < 4; ++m) { const f32x4* pp4 = (const f32x4*)(Pin + (size_t)(row0 + ai * 128 + m * 16) * 16); t[m][0] = pp4[0]; t[m][1] = pp4[1]; t[m][2] = pp4[2]; t[m][3] = pp4[3]; }
#pragma unroll
                    for (int m = 0; m < 4; ++m) {
                        const float sq = ((t[m][0][0] + t[m][0][1]) + (t[m][0][2] + t[m][0][3])) + ((t[m][1][0] + t[m][1][1]) + (t[m][1][2] + t[m][1][3])) + ((t[m][2][0] + t[m][2][1]) + (t[m][2][2] + t[m][2][3])) + ((t[m][3][0] + t[m][3][1]) + (t[m][3][2] + t[m][3][3]));
                        rsq[m] = rsqrtf(sq * (1.f / 1024.f) + EPSN);
                    }
                }
#pragma unroll
                for (int mh = 0; mh < 2; ++mh) {
                    f32x4 x0[4], x1[4]; u32x4 pq[4];
#pragma unroll
                    for (int q = 0; q < 4; ++q) {
                        const int m = 2 * mh + (q >> 1), bj = q & 1;
                        const size_t off = (size_t)(row0 + ai * 128 + m * 16) * DM + col0 + bj * 128;
                        x0[q] = *(const f32x4*)(Xin + off); x1[q] = *(const f32x4*)(Xin + off + 4); pq[q] = *(const u32x4*)(PP + off);
                    }
#pragma unroll
                    for (int q = 0; q < 4; ++q) {
                        const int m = 2 * mh + (q >> 1), bj = q & 1;
                        const size_t off = (size_t)(row0 + ai * 128 + m * 16) * DM + col0 + bj * 128;
                        const float rs = rsq[m];
                        const pg8::f32x4 v0 = acc[ai][bj][m][0], v1 = acc[ai][bj][m][1];
                        const u32x4 p = pq[q];
                        const float pv[8] = {lo16(p.x), hi16(p.x), lo16(p.y), hi16(p.y), lo16(p.z), hi16(p.z), lo16(p.w), hi16(p.w)};
                        f32x4 y0, y1;
#pragma unroll
                        for (int e = 0; e < 4; ++e) { y0[e] = x0[q][e] + sigmoidf_(v0[e] * rs) * pv[e]; y1[e] = x1[q][e] + sigmoidf_(v1[e] * rs) * pv[4 + e]; }
                        *(f32x4*)(Xout + off) = y0; *(f32x4*)(Xout + off + 4) = y1;
                    }
                }
            }
            return;
        }
        if (MODE == 6 || MODE == 3) {
            u32x4* sp = (u32x4*)SCR + ((wr * 4 + wc) * 64 + fq * 16 + fr) + ((MODE == 3 || (MODE == 6 && u.kind == 1)) ? 8192 : 0);
            if (MODE == 6 && u.kind != 2) {
                const float* bp = bias + (u.kind == 0 ? 0 : 1024) + col0;
#pragma unroll
                for (int bj = 0; bj < 2; ++bj) {
                    const f32x4 b0 = *(const f32x4*)(bp + bj * 128), b1 = *(const f32x4*)(bp + bj * 128 + 4);
#pragma unroll
                    for (int ai = 0; ai < 2; ++ai)
#pragma unroll
                        for (int m = 0; m < 4; ++m) {
                            const pg8::f32x4 v0 = acc[ai][bj][m][0], v1 = acc[ai][bj][m][1];
                            u32x4 w; w.x = pk2(sigmoidf_(v0[0] + b0[0]), sigmoidf_(v0[1] + b0[1])); w.y = pk2(sigmoidf_(v0[2] + b0[2]), sigmoidf_(v0[3] + b0[3]));
                            w.z = pk2(sigmoidf_(v1[0] + b1[0]), sigmoidf_(v1[1] + b1[1])); w.w = pk2(sigmoidf_(v1[2] + b1[2]), sigmoidf_(v1[3] + b1[3]));
                            sp[((ai * 4 + m) * 2 + bj) * 512] = w;
                        }
                }
            } else {
#pragma unroll
                for (int ai = 0; ai < 2; ++ai)
#pragma unroll
                    for (int mh = 0; mh < 2; ++mh) {
                        u32x4 gq[4], pq[4];
#pragma unroll
                        for (int q = 0; q < 4; ++q) {
                            const int m = 2 * mh + (q >> 1), bj = q & 1;
                            gq[q] = sp[((ai * 4 + m) * 2 + bj) * 512];
                            if (MODE == 3) pq[q] = *(const u32x4*)(O + (size_t)(row0 + ai * 128 + m * 16) * ldc + col0 + bj * 128);
                        }
#pragma unroll
                        for (int q = 0; q < 4; ++q) {
                            const int m = 2 * mh + (q >> 1), bj = q & 1;
                            bf16_t* op = O + (size_t)(row0 + ai * 128 + m * 16) * ldc + col0 + bj * 128;
                            const u32x4 g = gq[q];
                            const pg8::f32x4 v0 = acc[ai][bj][m][0], v1 = acc[ai][bj][m][1];
                            float r[8] = {lo16(g.x) * v0[0], hi16(g.x) * v0[1], lo16(g.y) * v0[2], hi16(g.y) * v0[3], lo16(g.z) * v1[0], hi16(g.z) * v1[1], lo16(g.w) * v1[2], hi16(g.w) * v1[3]};
                            if (MODE == 3) {
                                const u32x4 p = pq[q];
                                r[0] += lo16(p.x); r[1] += hi16(p.x); r[2] += lo16(p.y); r[3] += hi16(p.y); r[4] += lo16(p.z); r[5] += hi16(p.z); r[6] += lo16(p.w); r[7] += hi16(p.w);
                            }
                            u32x4 w; w.x = pk2(r[0], r[1]); w.y = pk2(r[2], r[3]); w.z = pk2(r[4], r[5]); w.w = pk2(r[6], r[7]);
                            *(u32x4*)op = w;
                        }
                    }
            }
            return;
        }
        f32x4 gv4[2][2];
        if (MODE == 4) {
#pragma unroll
            for (int bj = 0; bj < 2; ++bj) { gv4[bj][0] = *(const f32x4*)(gvec + col0 + bj * 128); gv4[bj][1] = *(const f32x4*)(gvec + col0 + bj * 128 + 4); }
        }
#pragma unroll
        for (int ai = 0; ai < 2; ++ai)
#pragma unroll
            for (int m = 0; m < 4; ++m) {
                const int row = row0 + ai * 128 + m * 16;
                float rs = 1.f;
                if (MODE == 5 || MODE == 7) {
                    const f32x4* pp = (const f32x4*)(Pin + (size_t)row * 16);
                    f32x4 a = pp[0], b = pp[1], c = pp[2], d = pp[3];
                    float s = ((a[0] + a[1]) + (a[2] + a[3])) + ((b[0] + b[1]) + (b[2] + b[3])) + ((c[0] + c[1]) + (c[2] + c[3])) + ((d[0] + d[1]) + (d[2] + d[3]));
                    rs = rsqrtf(s * (1.f / 1024.f) + EPSN);
                }
                float ssq = 0.f;
#pragma unroll
                for (int bj = 0; bj < 2; ++bj) {
                    const int col = col0 + bj * 128;
                    float v[8];
#pragma unroll
                    for (int e = 0; e < 4; ++e) { v[e] = acc[ai][bj][m][0][e]; v[4 + e] = acc[ai][bj][m][1][e]; }
                    if (MODE == 0) {
                        u32x4 w; w.x = pk2(v[0], v[1]); w.y = pk2(v[2], v[3]); w.z = pk2(v[4], v[5]); w.w = pk2(v[6], v[7]);
                        *(u32x4*)(O + (size_t)row * ldc + col) = w;
                    } else if (MODE == 4) {
                        const f32x4 g0 = gv4[bj][0], g1 = gv4[bj][1];
                        f32x4 y0, y1;
#pragma unroll
                        for (int e = 0; e < 4; ++e) { y0[e] = v[e]; y1[e] = v[4 + e]; ssq += y0[e] * y0[e] + y1[e] * y1[e]; }
                        *(f32x4*)(Xout + (size_t)row * DM + col) = y0; *(f32x4*)(Xout + (size_t)row * DM + col + 4) = y1;
                        u32x4 w; w.x = pk2(y0[0] * g0[0], y0[1] * g0[1]); w.y = pk2(y0[2] * g0[2], y0[3] * g0[3]); w.z = pk2(y1[0] * g1[0], y1[1] * g1[1]); w.w = pk2(y1[2] * g1[2], y1[3] * g1[3]);
                        *(u32x4*)(O + (size_t)row * ldc + col) = w;
                    } else if (MODE == 5) {
                        float r[8];
#pragma unroll
                        for (int e = 0; e < 8; ++e) { const float t = fmaxf(v[e] * rs, 0.f); r[e] = t * t; }
                        u32x4 w; w.x = pk2(r[0], r[1]); w.y = pk2(r[2], r[3]); w.z = pk2(r[4], r[5]); w.w = pk2(r[6], r[7]);
                        *(u32x4*)(O + (size_t)row * ldc + col) = w;
                    } else if (MODE == 7) {
                        const u32x4 p = *(const u32x4*)(PP + (size_t)row * DM + col);
                        const f32x4 x0 = *(const f32x4*)(Xin + (size_t)row * DM + col), x1 = *(const f32x4*)(Xin + (size_t)row * DM + col + 4);
                        const float pv[8] = {lo16(p.x), hi16(p.x), lo16(p.y), hi16(p.y), lo16(p.z), hi16(p.z), lo16(p.w), hi16(p.w)};
                        f32x4 y0, y1;
#pragma unroll
                        for (int e = 0; e < 4; ++e) { y0[e] = x0[e] + sigmoidf_(v[e] * rs) * pv[e]; y1[e] = x1[e] + sigmoidf_(v[4 + e] * rs) * pv[4 + e]; }
                        *(f32x4*)(Xout + (size_t)row * DM + col) = y0; *(f32x4*)(Xout + (size_t)row * DM + col + 4) = y1;
                    }
                }
                if (MODE == 4) {
                    ssq += __shfl_xor(ssq, 16); ssq += __shfl_xor(ssq, 32);
                    if (fq == 0) Pout[(size_t)row * 16 + u.pn * 4 + wc] = ssq;
                }
            }
    }
};


struct EpiHead {
    static constexpr bool PERM = true, AFTER_DRAIN = false;
    bf16_t* O; int ldc; int nrot; int sc_lo, sc_hi; int norm; const float* qgain; const float* kgain; float fdiv; LAS float* X;
    __device__ __forceinline__ void init(pg8::f32x4 (&acc)[2][2][4][2], const pg8::Unit& u, int wr, int wc, int fr, int fq) const {
#pragma unroll
        for (int a = 0; a < 2; ++a)
#pragma unroll
            for (int b = 0; b < 2; ++b)
#pragma unroll
                for (int m = 0; m < 4; ++m)
#pragma unroll
                    for (int n = 0; n < 2; ++n) acc[a][b][m][n] = (pg8::f32x4){0.f, 0.f, 0.f, 0.f};
    }
    __device__ __forceinline__ void operator()(const pg8::f32x4 (&acc)[2][2][4][2], const pg8::Unit& u, int wr, int wc, int fr, int fq) const {
        const int row0 = u.pm * 256 + wr * 64 + fr;
        if (u.pn >= nrot) {
            const int col0 = u.pn * 256 + wc * 32 + 8 * fq;
#pragma unroll
            for (int ai = 0; ai < 2; ++ai)
#pragma unroll
                for (int m = 0; m < 4; ++m)
#pragma unroll
                    for (int bj = 0; bj < 2; ++bj) {
                        u32x4 w; w.x = pk2(acc[ai][bj][m][0][0], acc[ai][bj][m][0][1]); w.y = pk2(acc[ai][bj][m][0][2], acc[ai][bj][m][0][3]);
                        w.z = pk2(acc[ai][bj][m][1][0], acc[ai][bj][m][1][1]); w.w = pk2(acc[ai][bj][m][1][2], acc[ai][bj][m][1][3]);
                        *(u32x4*)(O + (size_t)(row0 + ai * 128 + m * 16) * ldc + col0 + bj * 128) = w;
                    }
            return;
        }
        const int u4 = wc * 4 + fq;
        float fr4[4];
#pragma unroll
        for (int e = 0; e < 4; ++e) fr4[e] = exp2f(-(float)(4 * u4 + e) * (LOG2_THETA / fdiv)) * INV2PI;
        const float sc = (u.pn >= sc_lo && u.pn < sc_hi) ? QK_SCALE : 1.f;
        if (norm) {
#pragma unroll
            for (int ai = 0; ai < 2; ++ai)
#pragma unroll
                for (int m = 0; m < 4; ++m)
#pragma unroll
                    for (int bj = 0; bj < 2; ++bj) {
                        float s = 0.f;
#pragma unroll
                        for (int e = 0; e < 4; ++e) s += acc[ai][bj][m][0][e] * acc[ai][bj][m][0][e] + acc[ai][bj][m][1][e] * acc[ai][bj][m][1][e];
                        s += __shfl_xor(s, 16); s += __shfl_xor(s, 32);
                        if (fq == 0) X[((ai * 128 + wr * 64 + m * 16 + fr) * 2 + bj) * 4 + wc] = s;
                    }
            asm volatile("s_waitcnt lgkmcnt(0)" ::: "memory");
            __builtin_amdgcn_s_barrier();
        }
        f32x4 gh[2][2];
        if (norm) {
#pragma unroll
            for (int bj = 0; bj < 2; ++bj) { const int hb = u.pn * 256 + bj * 128;
                const float* gp = (hb < 1536 ? qgain + (hb >> 9) * 128 : kgain + ((hb - 1536) >> 9) * 128) + 4 * u4;
                gh[bj][0] = *(const f32x4*)gp; gh[bj][1] = *(const f32x4*)(gp + 64); }
        }
#pragma unroll
        for (int ai = 0; ai < 2; ++ai)
#pragma unroll
            for (int m = 0; m < 4; ++m) {
                const int row = row0 + ai * 128 + m * 16;
                const float pos = (float)(row & (SEQ - 1));
                float cs[4], sn[4];
#pragma unroll
                for (int e = 0; e < 4; ++e) { float r = pos * fr4[e]; r -= floorf(r); cs[e] = __builtin_amdgcn_cosf(r); sn[e] = __builtin_amdgcn_sinf(r); }
#pragma unroll
                for (int bj = 0; bj < 2; ++bj) {
                    const int hb = u.pn * 256 + bj * 128;
                    float x1[4], x2[4];
#pragma unroll
                    for (int e = 0; e < 4; ++e) { x1[e] = acc[ai][bj][m][0][e] * sc; x2[e] = acc[ai][bj][m][1][e] * sc; }
                    if (norm) {
                        const f32x4 pr = *(const LAS f32x4*)(X + ((ai * 128 + wr * 64 + m * 16 + fr) * 2 + bj) * 4);
                        const float rstd = rsqrtf(((pr[0] + pr[1]) + (pr[2] + pr[3])) * (1.f / 128.f) + EPSN);
                        const f32x4 g1 = gh[bj][0], g2 = gh[bj][1];
#pragma unroll
                        for (int e = 0; e < 4; ++e) { x1[e] *= rstd * g1[e]; x2[e] *= rstd * g2[e]; }
                    }
                    u32x2 w1, w2;
                    w1.x = pk2(x1[0] * cs[0] - x2[0] * sn[0], x1[1] * cs[1] - x2[1] * sn[1]); w1.y = pk2(x1[2] * cs[2] - x2[2] * sn[2], x1[3] * cs[3] - x2[3] * sn[3]);
                    w2.x = pk2(x2[0] * cs[0] + x1[0] * sn[0], x2[1] * cs[1] + x1[1] * sn[1]); w2.y = pk2(x2[2] * cs[2] + x1[2] * sn[2], x2[3] * cs[3] + x1[3] * sn[3]);
                    bf16_t* op = O + (size_t)row * ldc + hb + 4 * u4;
                    const auto s0 = __builtin_amdgcn_permlane16_swap(w1.x, w2.x, false, false);
                    const auto s1 = __builtin_amdgcn_permlane16_swap(w1.y, w2.y, false, false);
                    u32x4 wv; wv.x = s0[0]; wv.y = s1[0]; wv.z = s0[1]; wv.w = s1[1];
                    *(u32x4*)(op + ((fq & 1) ? 60 : 0)) = wv;
                }
            }
    }
};

#define XB_TMO      128
#define XB_XCNT(j)  (256  + 64 * (j))
#define XB_XSUB(j)  (1280 + 64 * (j))
#define XB_XGEN(j)  (2304 + 64 * (j))
#define XB_TOP      3328
#define XB_TOPGEN   3392
#define XCD_BAR_WORDS 3456
#define XB_SPIN_CAP (1u << 18)

__device__ __forceinline__ unsigned xb_ld(unsigned* p)              { return __hip_atomic_load(p, __ATOMIC_RELAXED, __HIP_MEMORY_SCOPE_AGENT); }
__device__ __forceinline__ unsigned xb_add(unsigned* p, unsigned v) { return __hip_atomic_fetch_add(p, v, __ATOMIC_RELAXED, __HIP_MEMORY_SCOPE_AGENT); }
__device__ __forceinline__ unsigned xb_xcc_id() { return (unsigned)__builtin_amdgcn_s_getreg((3 << 11) | 20) & 0xFu; }
#define XB_SPIN(cond, bar) do { unsigned _sp = 0; while (cond) { __builtin_amdgcn_s_sleep(1); \
    if ((++_sp & 255u) == 0u) { if (xb_ld(&(bar)[XB_TMO])) break; if (_sp > XB_SPIN_CAP) { atomicAdd(&(bar)[XB_TMO], 1u); break; } } } } while (0)

struct XcdBarrier {
    unsigned* bar; unsigned x;
    volatile LAS unsigned* st;
};

__device__ __forceinline__ XcdBarrier xcd_barrier_post(unsigned* bar, volatile LAS unsigned* st) {
    XcdBarrier b; b.bar = bar; b.x = xb_xcc_id(); b.st = st;
    if (threadIdx.x == 0) (void)xb_add(&bar[XB_XCNT(b.x)], 1u);
    return b;
}
__device__ __forceinline__ void xcd_barrier_complete(unsigned* bar, unsigned x, unsigned& nloc, unsigned& nx) {
    const unsigned G = gridDim.x * gridDim.y * gridDim.z;
    unsigned sum, cnt, mine, sp = 0u;
    for (;;) {
        sum = 0u; cnt = 0u; mine = 0u;
#pragma unroll
        for (unsigned j = 0; j < 16; ++j) { const unsigned c = xb_ld(&bar[XB_XCNT(j)]); sum += c; cnt += (c > 0u) ? 1u : 0u; mine = (j == x) ? c : mine; }
        if (sum == G) break;
        __builtin_amdgcn_s_sleep(1);
        if ((++sp & 255u) == 0u) { if (xb_ld(&bar[XB_TMO])) break; if (sp > XB_SPIN_CAP) { atomicAdd(&bar[XB_TMO], 1u); break; } }
    }
    nloc = mine > 0u ? mine : 1u; nx = cnt > 0u ? cnt : 1u;
}

__device__ __forceinline__ void xcd_barrier(const XcdBarrier& b) {
    asm volatile("s_waitcnt vmcnt(0)" ::: "memory");
    __syncthreads();
    if (threadIdx.x == 0) {
        unsigned* bar = b.bar;
        __builtin_amdgcn_s_waitcnt(0);
        unsigned nloc = b.st[0], nx = b.st[1];
        if (nloc == 0u) { xcd_barrier_complete(bar, b.x, nloc, nx); b.st[0] = nloc; b.st[1] = nx; }
        const unsigned mygen = b.st[2];
        const unsigned old = xb_add(&bar[XB_XSUB(b.x)], 1u);
        const unsigned gen = old / nloc;
        if (old + 1u == (gen + 1u) * nloc) {
            __builtin_amdgcn_fence(__ATOMIC_RELEASE, "agent");
            asm volatile("s_waitcnt vmcnt(0)" ::: "memory");
            const unsigned og = xb_add(&bar[XB_TOP], 1u);
            const unsigned tg = og / nx;
            if (og + 1u == (tg + 1u) * nx) xb_add(&bar[XB_TOPGEN], 1u);
        }
        XB_SPIN(xb_ld(&bar[XB_TOPGEN]) == mygen, bar);
        __builtin_amdgcn_fence(__ATOMIC_ACQUIRE, "agent");
        asm volatile("s_waitcnt vmcnt(0)" ::: "memory");
        b.st[2] = mygen + 1u;
    }
    __syncthreads();
}


__device__ __forceinline__ const bf16_t* da_src(const bf16_t* Z, int item, int ch) {
    const int sub = item & 31, hd = (item >> 5) & 3, gi = (item >> 7) % 3, b = item / 384;
    const int dl = gi == 0 ? 0 : (gi == 1 ? 2 : 4);
    const int d = 1 << dl, L = SEQ >> dl;
    const int r = sub & (d - 1), n = sub >> dl;
    const int row = ch >> 4, c16 = ch & 15;
    int lk = 128 * n - 128 + row; lk = lk < 0 ? 0 : (lk > L - 1 ? L - 1 : lk);
    return Z + ((size_t)b * SEQ + (size_t)lk * d + r) * ZA_W + gi * 512 + hd * 128 + c16 * 8;
}


struct Sched3 {
    pg8::StaticOrder S; const unsigned char* ws; const unsigned char* outp; int nk;
    __device__ bool next(int i, pg8::Unit& u) const { if (i >= nk) return false; if (!S.next(0, u)) return false; u.kind = i; return true; }
    __device__ __forceinline__ void a_ready(const pg8::Unit&) const {}
    __device__ __forceinline__ void done(const pg8::Unit&) const {}
    __device__ __forceinline__ const char* baseA(const pg8::Gemm&, const pg8::Unit& u) const { const long long dlt = (long long)(outp + 32 * MiB) - (long long)(ws + WS_H); return (const char*)(ws + WS_H) + (long long)(u.kind >> 1) * dlt; }
    __device__ __forceinline__ const char* baseB(const pg8::Gemm&, const pg8::Unit& u) const { return (const char*)(ws + WS_WIN + (size_t)7680 * DM * 2 + (size_t)u.kind * ((size_t)1024 * DM * 2)); }
};

struct Args {
    const float* x; const float* p; const float* w_in; const float* b_gate; const float* g_mix; const float* q_gain; const float* k_gain; const float* ret_gn;
    const float* w_ret_out; const float* w_att_out; const float* w_o; const float* g_mlp; const float* w_up; const float* w_down; const float* g_ple;
    const float* w_ple_proj; const float* w_ple_gate;
    float* out; unsigned char* ws; int ph_lo, ph_hi, li, dry8;
};

__device__ __forceinline__ u32x4 widen_pair(u32x2 a, u32x2 b) {
    const auto s0 = __builtin_amdgcn_permlane16_swap(a.x, b.x, false, false);
    const auto s1 = __builtin_amdgcn_permlane16_swap(a.y, b.y, false, false);
    u32x4 v; v.x = s0[0]; v.y = s1[0]; v.z = s0[1]; v.w = s1[1]; return v;
}
__device__ __forceinline__ float wave_sum(float v) {
#pragma unroll
    for (int o = 1; o < 64; o <<= 1) v += __shfl_xor(v, o);
    return v;
}

__device__ __forceinline__ int head_perm_row(int n) {
    const bool rot = (n < 1024) || (n >= 3072 && n < 6144);
    if (!rot) return n;
    const int j = n & 127, jj = j & 63;
    return (n & ~127) + 8 * (jj >> 2) + (jj & 3) + (j >= 64 ? 4 : 0);
}
template <bool HPERM>
__device__ __forceinline__ void p0_transpose_item(const float* W, int K, int N, bf16_t* WT, LAS float* scr, int item, int lane) {
    const int nblk = N / 32, kb = item / nblk, nb = item % nblk, k0 = 64 * kb, n0 = 32 * nb;
    { f32x4 t[8];
#pragma unroll
      for (int i = 0; i < 8; ++i) t[i] = *(const f32x4*)(W + (size_t)(k0 + 8 * i + (lane >> 3)) * N + n0 + 4 * (lane & 7));
#pragma unroll
      for (int i = 0; i < 8; ++i) { LAS float* d = scr + (8 * i + (lane >> 3)) * 33 + 4 * (lane & 7); d[0] = t[i][0]; d[1] = t[i][1]; d[2] = t[i][2]; d[3] = t[i][3]; } }
    asm volatile("s_waitcnt lgkmcnt(0)" ::: "memory");
    const int c = lane & 7;
#pragma unroll
    for (int j = 0; j < 4; ++j) { const int n = (lane >> 3) + 8 * j; const LAS float* s = scr + (8 * c) * 33 + n;
        u32x4 o; o.x = pk2(s[0 * 33], s[1 * 33]); o.y = pk2(s[2 * 33], s[3 * 33]); o.z = pk2(s[4 * 33], s[5 * 33]); o.w = pk2(s[6 * 33], s[7 * 33]);
        *(u32x4*)(WT + (size_t)(HPERM ? head_perm_row(n0 + n) : (n0 + n)) * K + k0 + 8 * c) = o; }
    asm volatile("s_waitcnt lgkmcnt(0)" ::: "memory");
}

__global__ void __launch_bounds__(512, 2) fwd_kernel(Args A) {
    extern __shared__ __attribute__((aligned(16))) unsigned char lds_raw[];
    LAS unsigned char* lds = (LAS unsigned char*)lds_raw;
    const int tid = threadIdx.x, lane = tid & 63, wave = __builtin_amdgcn_readfirstlane(tid >> 6);
    const int G = gridDim.x, bid = blockIdx.x;
    const int gw = bid * 8 + wave, NGW = G * 8;
    const int lo = A.ph_lo, hi = A.ph_hi;
    unsigned char* ws = A.ws;
    bf16_t* WinT = (bf16_t*)(ws + WS_WIN); bf16_t* WretT = (bf16_t*)(ws + WS_WRET); bf16_t* WattT = (bf16_t*)(ws + WS_WATT); bf16_t* WoT = (bf16_t*)(ws + WS_WO);
    bf16_t* WupT = (bf16_t*)(ws + WS_WUP); bf16_t* WdnT = (bf16_t*)(ws + WS_WDN); bf16_t* WpgT = (bf16_t*)(ws + WS_WPG); bf16_t* WppT = (bf16_t*)(ws + WS_WPP);
    bf16_t* PBF = (bf16_t*)(ws + WS_PBF); bf16_t* HB = (bf16_t*)(ws + WS_H); bf16_t* Z = (bf16_t*)(ws + WS_Z); bf16_t* PREV = (bf16_t*)(ws + WS_PREV);
    bf16_t* MERGED = (bf16_t*)(ws + WS_MERGED); bf16_t* PPB = (bf16_t*)(ws + WS_PP);
    float* LSE = (float*)(ws + WS_LSE); float* SSQ1 = (float*)(ws + WS_SSQ1); float* SSQ2 = (float*)(ws + WS_SSQ2);
    bf16_t* KV = (bf16_t*)A.out;
    bf16_t* OATT = (bf16_t*)A.out;
    bf16_t* YG = (bf16_t*)((unsigned char*)A.out + 32 * MiB);
    cg::grid_group grid = cg::this_grid();
#define IN(k) (lo <= (k) && (k) < hi)
#define SEAM(k) do { if (IN(k) && IN((k) + 1)) xcd_barrier(bar); } while (0)
    volatile LAS unsigned* bst = (volatile LAS unsigned*)(lds + (LDS_BYTES - 64));
    if (tid == 0) { bst[0] = 0u; bst[1] = 0u; bst[2] = 0u; }
    __syncthreads();
    XcdBarrier bar = xcd_barrier_post((unsigned*)(ws + WS_BAR + (size_t)A.li * BAR_STRIDE), bst);
    if (lo > hi) grid.sync();

    if (IN(0)) {
        LAS float* scr = (LAS float*)(lds + wave * 16384);
        constexpr int I_IN = (DM / 64) * (DIN / 32), I_RET = (1024 / 64) * (DM / 32), I_ATT = (512 / 64) * (DM / 32), I_O = (DM / 64) * (DM / 32), I_UP = (DM / 64) * (DFF / 32),
                      I_DN = (DFF / 64) * (DM / 32), I_PG = (DM / 64) * (DM / 32), I_PP = (PLE / 64) * (DM / 32);
        for (int it = gw; it < I_IN; it += NGW) p0_transpose_item<true>(A.w_in, DM, DIN, WinT, scr, it, lane);
        for (int m = gw; m < MTOK; m += NGW) {
            const f32x4* xr = (const f32x4*)(A.x + (size_t)m * DM) + 2 * lane;
            const f32x4* gr = (const f32x4*)A.g_mix + 2 * lane;
            f32x4 v[4]; float s = 0.f;
#pragma unroll
            for (int j = 0; j < 2; ++j) { v[2 * j] = xr[128 * j]; v[2 * j + 1] = xr[128 * j + 1]; }
#pragma unroll
            for (int j = 0; j < 4; ++j) s += (v[j][0] * v[j][0] + v[j][1] * v[j][1]) + (v[j][2] * v[j][2] + v[j][3] * v[j][3]);
            const float rstd = rsqrtf(wave_sum(s) * (1.f / DM) + EPSN);
            u32x4* o16 = (u32x4*)(HB + (size_t)m * DM) + lane;
#pragma unroll
            for (int j = 0; j < 2; ++j) { const f32x4 g0 = gr[128 * j], g1 = gr[128 * j + 1]; const f32x4 a = v[2 * j], b = v[2 * j + 1]; u32x4 w;
                w.x = pk2(a[0] * rstd * g0[0], a[1] * rstd * g0[1]); w.y = pk2(a[2] * rstd * g0[2], a[3] * rstd * g0[3]);
                w.z = pk2(b[0] * rstd * g1[0], b[1] * rstd * g1[1]); w.w = pk2(b[2] * rstd * g1[2], b[3] * rstd * g1[3]); o16[64 * j] = w; }
        }
    }
    SEAM(0);
#ifdef XBAR
    for (int i = 0; i < XBAR; ++i) xcd_barrier(bar);
#endif

    if (IN(1)) {
        pg8::Gemm g{HB, WinT, MTOK, ZR_W, DM}; pg8::StaticOrder S; S.init(MTOK, ZR_W, G, bid, 4);
        EpiHead E{}; E.O = Z; E.ldc = ZR_W; E.nrot = 4; E.sc_lo = 2; E.sc_hi = 4; E.norm = 0; E.fdiv = 63.f; E.X = (LAS float*)(lds + 131072);
        pg8::gemm_phase<EpiHead, pg8::StaticOrder, true, true>(lds, g, S, E);
    }
    SEAM(1);

    if (IN(3)) {
        LAS unsigned char* Ks = lds; LAS unsigned char* Vs = lds + 36864;
        const int g4 = lane >> 4, qq = (lane & 15) >> 2, pp = lane & 3;
        for (int item = bid; item < 512; item += G) {
            const int b = item >> 7, h = (item >> 5) & 3, n = item & 31;
            const size_t tok0 = (size_t)b * SEQ + n * 128;
            const float lg2 = ret_lg2(h);
            __syncthreads();
            for (int ch = tid; ch < 128 * 16; ch += 512) {
                const int row = ch >> 4, c16 = ch & 15;
                const u32x4 v = *(const u32x4*)(Z + (tok0 + row) * ZR_W + 512 + h * 128 + c16 * 8);
                const float dec = exp2f(lg2 * (float)(127 - row));
                u32x4 w; w.x = pk2(lo16(v.x) * dec, hi16(v.x) * dec); w.y = pk2(lo16(v.y) * dec, hi16(v.y) * dec); w.z = pk2(lo16(v.z) * dec, hi16(v.z) * dec); w.w = pk2(lo16(v.w) * dec, hi16(v.w) * dec);
                *(LAS u32x4*)(Ks + row * 288 + c16 * 16) = w;
            }
            for (int ch = tid; ch < 128 * 32; ch += 512) {
                const int row = ch >> 5, c32 = ch & 31;
                *(LAS u32x4*)(Vs + row * 544 + c32 * 16) = *(const u32x4*)(Z + (tok0 + row) * ZR_W + 1024 + h * 256 + c32 * 8);
            }
            __syncthreads();
            bf16x8 bfr[2][4];
#pragma unroll
            for (int cc = 0; cc < 2; ++cc)
#pragma unroll
                for (int s = 0; s < 4; ++s) { const LAS unsigned char* vb = Vs + (32 * s + 8 * g4 + qq) * 544 + (16 * (2 * wave + cc) + 4 * pp) * 2; bfr[cc][s] = cat8(tr4(vb), tr4(vb + 4 * 544)); }
            bf16_t* kvb = KV + (size_t)item * 32768 + (size_t)(lane & 15) * 128 + 4 * g4 + ((g4 & 1) ? 12 : 0);
#pragma unroll 2
            for (int t = 0; t < 8; t += 2) {
                f32x4 a00 = {0.f, 0.f, 0.f, 0.f}, a01 = a00, a10 = a00, a11 = a00;
#pragma unroll
                for (int s = 0; s < 4; ++s) {
                    const LAS unsigned char* kb = Ks + (32 * s + 8 * g4 + qq) * 288 + (16 * t + 4 * pp) * 2;
                    const bf16x8 A0 = cat8(tr4(kb), tr4(kb + 4 * 288)), A1 = cat8(tr4(kb + 32), tr4(kb + 32 + 4 * 288));
                    a00 = mfma16(A0, bfr[0][s], a00); a01 = mfma16(A0, bfr[1][s], a01); a10 = mfma16(A1, bfr[0][s], a10); a11 = mfma16(A1, bfr[1][s], a11);
                }
                u32x2 wa, wb;
                wa.x = pk2(a00[0], a00[1]); wa.y = pk2(a00[2], a00[3]); wb.x = pk2(a10[0], a10[1]); wb.y = pk2(a10[2], a10[3]);
                *(u32x4*)(kvb + (size_t)(16 * (2 * wave)) * 128 + 16 * t) = widen_pair(wa, wb);
                wa.x = pk2(a01[0], a01[1]); wa.y = pk2(a01[2], a01[3]); wb.x = pk2(a11[0], a11[1]); wb.y = pk2(a11[2], a11[3]);
                *(u32x4*)(kvb + (size_t)(16 * (2 * wave + 1)) * 128 + 16 * t) = widen_pair(wa, wb);
            }
        }
    }
    SEAM(3);

    if (IN(4)) {
        for (int idx = bid * 512 + tid; idx < 16 * 8192; idx += G * 512) {
            const int bh = idx >> 13, rem = idx & 8191;
            const float cd = exp2f(ret_lg2(bh & 3) * 128.f);
            f32x4 st = {0.f, 0.f, 0.f, 0.f};
            const size_t base = (size_t)bh * 32 * 32768 + (size_t)rem * 4;
#pragma unroll 1
            for (int n0 = 0; n0 < 32; n0 += 16) {
                f32x4 kv[16];
#pragma unroll
                for (int j = 0; j < 16; ++j) { const u32x2 t = *(const u32x2*)(KV + base + (size_t)(n0 + j) * 32768); kv[j] = (f32x4){lo16(t.x), hi16(t.x), lo16(t.y), hi16(t.y)}; }
#pragma unroll
                for (int j = 0; j < 16; ++j) {
                    u32x2 w; w.x = pk2(st[0], st[1]); w.y = pk2(st[2], st[3]);
                    *(u32x2*)(PREV + base + (size_t)(n0 + j) * 32768) = w;
                    st = st * cd + kv[j];
                }
            }
        }
    }
    SEAM(4);

    if (IN(5)) {
        LAS unsigned char* Vs = lds; LAS unsigned char* Ps = lds + 69632;
        const int g4 = lane >> 4, qi = lane & 15, qq = (lane & 15) >> 2, pp = lane & 3;
        for (int item = bid; item < 512; item += G) {
            const int b = item >> 7, h = (item >> 5) & 3, n = item & 31;
            const size_t tok0 = (size_t)b * SEQ + n * 128;
            const float lg2 = ret_lg2(h);
            u32x4 sv[8], sp_[8];
#pragma unroll
            for (int i = 0; i < 8; ++i) { const int ch = tid + 512 * i; sv[i] = *(const u32x4*)(Z + (tok0 + (ch >> 5)) * ZR_W + 1024 + h * 256 + (ch & 31) * 8); }
#pragma unroll
            for (int i = 0; i < 8; ++i) { const int ch = tid + 512 * i; sp_[i] = *(const u32x4*)(PREV + (size_t)item * 32768 + (ch >> 4) * 128 + (ch & 15) * 8); }
            const int iq = 16 * wave + qi;
            const size_t tokq = tok0 + iq;
            bf16x8 qf[4];
#pragma unroll
            for (int kk = 0; kk < 4; ++kk) qf[kk] = *(const bf16x8*)(Z + tokq * ZR_W + h * 128 + 32 * kk + 8 * g4);
            bf16x8 pf[4];
            {
                f32x4 st[8];
#pragma unroll
                for (int kt = 0; kt < 8; ++kt) {
                    f32x4 a = {0.f, 0.f, 0.f, 0.f};
                    if (kt <= wave) {
                        const bf16_t* kp = Z + (tok0 + 16 * kt + qi) * ZR_W + 512 + h * 128 + 8 * g4;
#pragma unroll
                        for (int kk = 0; kk < 4; ++kk) a = mfma16(*(const bf16x8*)(kp + 32 * kk), qf[kk], a);
#pragma unroll
                        for (int e = 0; e < 4; ++e) { const int diff = iq - (16 * kt + 4 * g4 + e); a[e] = diff >= 0 ? a[e] * __builtin_amdgcn_exp2f(lg2 * (float)diff) : 0.f; }
                    }
                    st[kt] = a;
                }
#pragma unroll
                for (int s = 0; s < 4; ++s) { u32x4 w; w.x = pk2(st[2 * s][0], st[2 * s][1]); w.y = pk2(st[2 * s][2], st[2 * s][3]); w.z = pk2(st[2 * s + 1][0], st[2 * s + 1][1]); w.w = pk2(st[2 * s + 1][2], st[2 * s + 1][3]); pf[s] = __builtin_bit_cast(bf16x8, w); }
            }
            __syncthreads();
#pragma unroll
            for (int i = 0; i < 8; ++i) { const int ch = tid + 512 * i; *(LAS u32x4*)(Vs + (ch >> 5) * 544 + (ch & 31) * 16) = sv[i]; }
#pragma unroll
            for (int i = 0; i < 8; ++i) { const int ch = tid + 512 * i; *(LAS u32x4*)(Ps + (ch >> 4) * 272 + (ch & 15) * 16) = sp_[i]; }
            __syncthreads();
            f32x4 acc[16];
            const LAS unsigned char* pv = Ps + qi * 272 + 16 * g4;
#pragma unroll
            for (int c = 0; c < 16; ++c) {
                f32x4 a = {0.f, 0.f, 0.f, 0.f};
#pragma unroll
                for (int kk = 0; kk < 4; ++kk) a = mfma16(*(const LAS bf16x8*)(pv + c * 16 * 272 + 64 * kk), qf[kk], a);
                acc[c] = a;
            }
            const float qd = exp2f(lg2 * (float)(iq + 1));
#pragma unroll
            for (int c = 0; c < 16; ++c) acc[c] = acc[c] * qd;
#pragma unroll
            for (int s = 0; s < 4; ++s) {
                if (2 * s <= wave) {
                    const LAS unsigned char* vb = Vs + (32 * s + 4 * g4 + qq) * 544 + pp * 8;
#pragma unroll
                    for (int c = 0; c < 16; ++c) acc[c] = mfma16(cat8(tr4(vb + c * 32), tr4(vb + 16 * 544 + c * 32)), pf[s], acc[c]);
                }
            }
            float ssq = 0.f;
#pragma unroll
            for (int c = 0; c < 16; ++c) ssq += (acc[c][0] * acc[c][0] + acc[c][1] * acc[c][1]) + (acc[c][2] * acc[c][2] + acc[c][3] * acc[c][3]);
            ssq += __shfl_xor(ssq, 16); ssq += __shfl_xor(ssq, 32);
            const float rstd = rsqrtf(ssq * (1.f / 256.f) + EPSN);
            const bf16_t* rgp = Z + tokq * ZR_W + 2048 + h * 256 + 4 * g4;
            const float* gnp = A.ret_gn + h * 256 + 4 * g4;
            bf16_t* yo = YG + tokq * 1024 + h * 256 + 4 * g4;
#pragma unroll
            for (int cb = 0; cb < 2; ++cb) {
                u32x2 rgv[8]; f32x4 gnv[8];
#pragma unroll
                for (int c8 = 0; c8 < 8; ++c8) { rgv[c8] = *(const u32x2*)(rgp + 16 * (8 * cb + c8)); gnv[c8] = *(const f32x4*)(gnp + 16 * (8 * cb + c8)); }
#pragma unroll
                for (int c8 = 0; c8 < 8; c8 += 2) {
                    u32x2 wp[2];
#pragma unroll
                    for (int t2 = 0; t2 < 2; ++t2) {
                        const int c = 8 * cb + c8 + t2;
                        const u32x2 rg = rgv[c8 + t2];
                        const f32x4 gn = gnv[c8 + t2];
                        const float r0 = lo16(rg.x), r1 = hi16(rg.x), r2 = lo16(rg.y), r3 = hi16(rg.y);
                        wp[t2].x = pk2(r0 * sigmoidf_(r0) * (acc[c][0] * rstd * gn[0]), r1 * sigmoidf_(r1) * (acc[c][1] * rstd * gn[1]));
                        wp[t2].y = pk2(r2 * sigmoidf_(r2) * (acc[c][2] * rstd * gn[2]), r3 * sigmoidf_(r3) * (acc[c][3] * rstd * gn[3]));
                    }
                    *(u32x4*)(yo + 16 * (8 * cb + c8) + ((g4 & 1) ? 12 : 0)) = widen_pair(wp[0], wp[1]);
                }
            }
        }
    }
    SEAM(5);

    if (IN(6)) {
        pg8::Gemm g{HB, WinT + (size_t)3072 * DM, MTOK, ZA_W, DM}; pg8::StaticOrder S; S.init(MTOK, ZA_W, G, bid, 4);
        EpiHead E{}; E.O = Z; E.ldc = ZA_W; E.nrot = 12; E.sc_lo = 0; E.sc_hi = 6; E.norm = 1; E.qgain = A.q_gain; E.kgain = A.k_gain; E.fdiv = 64.f; E.X = (LAS float*)(lds + 131072);
        pg8::gemm_phase<EpiHead, pg8::StaticOrder, true, true>(lds, g, S, E);
        if (bid >= G / 2) {
            __syncthreads();
            LAS float* scr = (LAS float*)(lds + wave * 16384);
            constexpr int I_RET = (1024 / 64) * (DM / 32), I_ATT = (512 / 64) * (DM / 32), I_O = (DM / 64) * (DM / 32), I_UP = (DM / 64) * (DFF / 32),
                          I_DN = (DFF / 64) * (DM / 32), I_PG = (DM / 64) * (DM / 32), I_PP = (PLE / 64) * (DM / 32);
            constexpr int NITEMS = I_RET + I_ATT + I_O + I_UP + I_DN + I_PG + I_PP;
            for (int it = (bid - G / 2) * 8 + wave; it < NITEMS; it += (G / 2) * 8) {
                int r = it;
                if (r < I_RET) { p0_transpose_item<false>(A.w_ret_out, 1024, DM, WretT, scr, r, lane); continue; } r -= I_RET;
                if (r < I_ATT) { p0_transpose_item<false>(A.w_att_out, 512, DM, WattT, scr, r, lane); continue; } r -= I_ATT;
                if (r < I_O) { p0_transpose_item<false>(A.w_o, DM, DM, WoT, scr, r, lane); continue; } r -= I_O;
                if (r < I_UP) { p0_transpose_item<false>(A.w_up, DM, DFF, WupT, scr, r, lane); continue; } r -= I_UP;
                if (r < I_DN) { p0_transpose_item<false>(A.w_down, DFF, DM, WdnT, scr, r, lane); continue; } r -= I_DN;
                if (r < I_PG) { p0_transpose_item<false>(A.w_ple_gate, DM, DM, WpgT, scr, r, lane); continue; } r -= I_PG;
                p0_transpose_item<false>(A.w_ple_proj, PLE, DM, WppT, scr, r, lane);
            }
        for (size_t i = (size_t)(bid - G / 2) * 512 + tid; i < (size_t)MTOK * PLE / 8; i += (size_t)(G / 2) * 512) {
            const f32x4 a = ((const f32x4*)A.p)[2 * i], b = ((const f32x4*)A.p)[2 * i + 1];
            u32x4 w; w.x = pk2(a[0], a[1]); w.y = pk2(a[2], a[3]); w.z = pk2(b[0], b[1]); w.w = pk2(b[2], b[3]);
            ((u32x4*)PBF)[i] = w;
        }
        }
    }
    SEAM(6);

    if (IN(8)) {
        LAS unsigned char* Vs = lds; LAS unsigned char* Ks = lds + 78336;
        const int g4 = lane >> 4, qi = lane & 15, qq = (lane & 15) >> 2, pp = lane & 3;
        const int vcu = (G & 7) == 0 ? (bid & 7) * (G >> 3) + (bid >> 3) : bid;
        u32x4 kr[8], vr[8];
        for (int i = tid; i < 16 * 18; i += 512) *(LAS u32x4*)(Vs + 256 * 288 + i * 16) = (u32x4){0u, 0u, 0u, 0u};
        for (int i = tid; i < 16 * 17; i += 512) *(LAS u32x4*)(Ks + 256 * 272 + i * 16) = (u32x4){0u, 0u, 0u, 0u};
        if (vcu < 1536) {
#pragma unroll
            for (int i = 0; i < 8; ++i) { const int ch = tid + 512 * i; { const bf16_t* src = da_src(Z, vcu, ch); vr[i] = *(const u32x4*)(src + 3072); kr[i] = *(const u32x4*)(src + 1536); } }
        }
        for (int item = vcu; item < 1536; item += G) {
            const int sub = item & 31, hd = (item >> 5) & 3, gi = (item >> 7) % 3, b = item / 384;
            const int dl = gi == 0 ? 0 : (gi == 1 ? 2 : 4);
            const int d = 1 << dl;
            const int r = sub & (d - 1), n = sub >> dl;
            const size_t tb = (size_t)b * SEQ;
            const int lq = 128 * n + 16 * wave + qi;
            const size_t tq = tb + (size_t)lq * d + r;
            bf16_t* qp = Z + tq * ZA_W + gi * 512 + hd * 128;
            bf16x8 qf[4];
#pragma unroll
            for (int kk = 0; kk < 4; ++kk) qf[kk] = *(const bf16x8*)(qp + 32 * kk + 8 * g4);
            __syncthreads();
#pragma unroll
            for (int i = 0; i < 8; ++i) { const int ch = tid + 512 * i; { const int row = ch >> 4, c16 = ch & 15;
                *(LAS u32x4*)(Vs + row * 288 + c16 * 16) = vr[i]; *(LAS u32x4*)(Ks + row * 272 + c16 * 16) = kr[i]; } }
            __syncthreads();
            if (item + G < 1536) {
#pragma unroll
                for (int i = 0; i < 8; ++i) { const int ch = tid + 512 * i; { const bf16_t* src = da_src(Z, item + G, ch); vr[i] = *(const u32x4*)(src + 3072); kr[i] = *(const u32x4*)(src + 1536); } }
            }
            f32x4 st[10];
            const int lk0 = 128 * n + 16 * wave - 128;
#pragma unroll
            for (int kt = 0; kt < 10; ++kt) {
                const LAS unsigned char* kp = Ks + (16 * wave + 16 * kt + qi) * 272 + 16 * g4;
                f32x4 a = {0.f, 0.f, 0.f, 0.f};
#pragma unroll
                for (int kk = 0; kk < 4; ++kk) a = mfma16(*(const LAS bf16x8*)(kp + 64 * kk), qf[kk], a);
                st[kt] = a;
            }
            float mx = -1e30f;
#pragma unroll
            for (int kt = 0; kt < 10; ++kt)
#pragma unroll
                for (int e = 0; e < 4; ++e) {
                    const int dist = 128 + qi - 16 * kt - 4 * g4 - e;
                    const int lkk = lk0 + 16 * kt + 4 * g4 + e;
                    const bool ok = dist >= 0 && dist <= 128 && lkk >= 0;
                    const float sv = ok ? st[kt][e] : -1e30f;
                    st[kt][e] = sv; mx = fmaxf(mx, sv);
                }
            mx = fmaxf(mx, __shfl_xor(mx, 16)); mx = fmaxf(mx, __shfl_xor(mx, 32));
            float sum = 0.f;
#pragma unroll
            for (int kt = 0; kt < 10; ++kt)
#pragma unroll
                for (int e = 0; e < 4; ++e) { const float pe = __builtin_amdgcn_exp2f((st[kt][e] - mx) * LOG2E); st[kt][e] = pe; sum += pe; }
            sum += __shfl_xor(sum, 16); sum += __shfl_xor(sum, 32);
            const float inv = 1.f / sum;
            bf16x8 pf[5];
#pragma unroll
            for (int s = 0; s < 5; ++s) { u32x4 w; w.x = pk2(st[2 * s][0] * inv, st[2 * s][1] * inv); w.y = pk2(st[2 * s][2] * inv, st[2 * s][3] * inv);
                w.z = pk2(st[2 * s + 1][0] * inv, st[2 * s + 1][1] * inv); w.w = pk2(st[2 * s + 1][2] * inv, st[2 * s + 1][3] * inv); pf[s] = __builtin_bit_cast(bf16x8, w); }
            f32x4 o[8];
#pragma unroll
            for (int c = 0; c < 8; ++c) o[c] = (f32x4){0.f, 0.f, 0.f, 0.f};
#pragma unroll
            for (int s = 0; s < 5; ++s) {
                const LAS unsigned char* vb = Vs + (16 * wave + 32 * s + 4 * g4 + qq) * 288 + pp * 8;
#pragma unroll
                for (int c = 0; c < 8; ++c) o[c] = mfma16(cat8(tr4(vb + c * 32), tr4(vb + 16 * 288 + c * 32)), pf[s], o[c]);
            }
#pragma unroll
            for (int c = 0; c < 8; c += 2) { u32x2 wa, wb; wa.x = pk2(o[c][0], o[c][1]); wa.y = pk2(o[c][2], o[c][3]); wb.x = pk2(o[c + 1][0], o[c + 1][1]); wb.y = pk2(o[c + 1][2], o[c + 1][3]);
                const u32x4 wv = widen_pair(wa, wb); if (!A.dry8) *(u32x4*)(qp + 16 * c + 4 * g4 + ((g4 & 1) ? 12 : 0)) = wv; }
            if (g4 == 0 && !A.dry8) LSE[tq * 12 + gi * 4 + hd] = mx + __logf(sum);
        }
    }
    SEAM(8);

    if (IN(9)) {
        for (int idx = bid * 512 + tid; idx < MTOK * 64; idx += G * 512) {
            const int m = idx >> 6, hd = (idx >> 4) & 3, ch = idx & 15;
            const float l0 = LSE[(size_t)m * 12 + hd], l1 = LSE[(size_t)m * 12 + 4 + hd], l2 = LSE[(size_t)m * 12 + 8 + hd];
            const float mx = fmaxf(l0, fmaxf(l1, l2));
            float w0 = __expf(l0 - mx), w1 = __expf(l1 - mx), w2 = __expf(l2 - mx);
            const float inv = 1.f / (w0 + w1 + w2); w0 *= inv; w1 *= inv; w2 *= inv;
            const bf16_t* zp = Z + (size_t)m * ZA_W + hd * 128 + ch * 8;
            const u32x4 a = *(const u32x4*)zp, b2 = *(const u32x4*)(zp + 512), c2 = *(const u32x4*)(zp + 1024);
            u32x4 w;
            w.x = pk2(w0 * lo16(a.x) + w1 * lo16(b2.x) + w2 * lo16(c2.x), w0 * hi16(a.x) + w1 * hi16(b2.x) + w2 * hi16(c2.x));
            w.y = pk2(w0 * lo16(a.y) + w1 * lo16(b2.y) + w2 * lo16(c2.y), w0 * hi16(a.y) + w1 * hi16(b2.y) + w2 * hi16(c2.y));
            w.z = pk2(w0 * lo16(a.z) + w1 * lo16(b2.z) + w2 * lo16(c2.z), w0 * hi16(a.z) + w1 * hi16(b2.z) + w2 * hi16(c2.z));
            w.w = pk2(w0 * lo16(a.w) + w1 * lo16(b2.w) + w2 * lo16(c2.w), w0 * hi16(a.w) + w1 * hi16(b2.w) + w2 * hi16(c2.w));
            *(u32x4*)(OATT + (size_t)m * 512 + hd * 128 + ch * 8) = w;
        }
    }
    SEAM(9);

    if (IN(11)) {
        bf16_t* SCR = Z + (size_t)bid * 131072;
        {
            pg8::Gemm g{HB, WinT, MTOK, DM, DM};
            Sched3 S3; S3.S.init(MTOK, DM, G, bid); S3.ws = ws; S3.outp = (const unsigned char*)A.out; S3.nk = lo < 0 ? 2 : 3;
            Epi<6> E{}; E.O = MERGED; E.ldc = DM; E.SCR = SCR; E.bias = A.b_gate;
            pg8::gemm_phase<Epi<6>, Sched3, true, true>(lds, g, S3, E);
        }
        __syncthreads();
        {
            pg8::Gemm g{OATT, WattT, MTOK, DM, 512}; pg8::StaticOrder S; S.init(MTOK, DM, G, bid);
            Epi<3> E{}; E.O = MERGED; E.ldc = DM; E.SCR = SCR;
            pg8::gemm_phase<Epi<3>, pg8::StaticOrder, true, true>(lds, g, S, E);
        }
    }
    SEAM(11);

    if (IN(12)) {
        pg8::Gemm g{MERGED, WoT, MTOK, DM, DM}; pg8::StaticOrder S; S.init(MTOK, DM, G, bid);
        Epi<4> E{}; E.O = HB; E.ldc = DM; E.Xin = A.x; E.Xout = A.out; E.gvec = A.g_mlp; E.Pout = SSQ1;
        pg8::gemm_phase<Epi<4>, pg8::StaticOrder, true, true>(lds, g, S, E);
        __syncthreads();
        {
            pg8::Gemm g2{PBF, WppT, MTOK, DM, lo < 0 ? 512 : PLE};     pg8::StaticOrder S2; S2.init(MTOK, DM, G, bid);
            Epi<0> E2{}; E2.O = PPB; E2.ldc = DM;
            pg8::gemm_phase<Epi<0>, pg8::StaticOrder, true, true>(lds, g2, S2, E2);
        }
    }
    SEAM(12);

    if (IN(13)) {
        pg8::Gemm g{HB, WupT, MTOK, DFF, DM}; pg8::StaticOrder S; S.init(MTOK, DFF, G, bid, 4);
        Epi<5> E{}; E.O = Z; E.ldc = DFF; E.Pin = SSQ1;
        pg8::gemm_phase<Epi<5>, pg8::StaticOrder, true, true>(lds, g, S, E);
    }
    SEAM(13);

    if (IN(14)) {
        {
            pg8::Gemm g{Z, WdnT, MTOK, DM, DFF}; pg8::StaticOrder S; S.init(MTOK, DM, G, bid);
            Epi<4> E{}; E.O = HB; E.ldc = DM; E.Xin = A.out; E.Xout = A.out; E.gvec = A.g_ple; E.Pout = SSQ2;
            pg8::gemm_phase<Epi<4>, pg8::StaticOrder, true, true>(lds, g, S, E);
        }
    }
    SEAM(14);

    if (IN(15)) {
        pg8::Gemm g{HB, WpgT, MTOK, DM, DM}; pg8::StaticOrder S; S.init(MTOK, DM, G, bid);
        Epi<7> E{}; E.Xin = A.out; E.Xout = A.out; E.Pin = SSQ2; E.PP = PPB;
        pg8::gemm_phase<Epi<7>, pg8::StaticOrder, true, true>(lds, g, S, E);
    }
#undef IN
#undef SEAM
}

#ifndef N_LAUNCH_MODE
#define N_LAUNCH_MODE 1
#endif
constexpr int N_PHASES = 16;

extern "C" void kernel_launch(void* const* d_in, const int* in_sizes, int n_in, void* d_out, int out_size, void* d_ws, size_t ws_size, hipStream_t stream) {
    static int grid = 0;
    if (grid == 0) {
        int dev = 0, cus = 0, per_cu = 0;
        hipGetDevice(&dev);
        hipDeviceGetAttribute(&cus, hipDeviceAttributeMultiprocessorCount, dev);
        if (hipFuncSetAttribute((const void*)fwd_kernel, hipFuncAttributeMaxDynamicSharedMemorySize, LDS_BYTES) != hipSuccess) fprintf(stderr, "kernel_launch: hipFuncSetAttribute failed\n");
        if (hipOccupancyMaxActiveBlocksPerMultiprocessor(&per_cu, (const void*)fwd_kernel, 512, LDS_BYTES) != hipSuccess || per_cu < 1) { fprintf(stderr, "kernel_launch: occupancy query says %d\n", per_cu); per_cu = 1; }
        (void)hipGetLastError();
        grid = cus * 1;
        if (ws_size < WS_END) fprintf(stderr, "kernel_launch: workspace too small (%zu)\n", ws_size);
    }
    Args a{};
    a.x = (const float*)d_in[0]; a.p = (const float*)d_in[1]; a.w_in = (const float*)d_in[2]; a.b_gate = (const float*)d_in[3]; a.g_mix = (const float*)d_in[4];
    a.q_gain = (const float*)d_in[5]; a.k_gain = (const float*)d_in[6]; a.ret_gn = (const float*)d_in[7]; a.w_ret_out = (const float*)d_in[8]; a.w_att_out = (const float*)d_in[9];
    a.w_o = (const float*)d_in[10]; a.g_mlp = (const float*)d_in[11]; a.w_up = (const float*)d_in[12]; a.w_down = (const float*)d_in[13]; a.g_ple = (const float*)d_in[14];
    a.w_ple_proj = (const float*)d_in[15]; a.w_ple_gate = (const float*)d_in[16];
    a.out = (float*)d_out; a.ws = (unsigned char*)d_ws;
    if (hipMemsetAsync((char*)d_ws + WS_BAR, 0, BAR_STRIDE * BAR_MAXL, stream) != hipSuccess) fprintf(stderr, "kernel_launch: memset failed\n");
#ifdef PROBE_CUTS
    { static const int cuts[][2] = PROBE_CUTS;
      for (unsigned i = 0; i < sizeof(cuts) / sizeof(cuts[0]); ++i) {
          a.ph_lo = cuts[i][0]; a.ph_hi = cuts[i][1]; a.li = (int)i;
#ifdef PROBE_DRY8
          a.dry8 = (i == 0);
#endif
          void* args[] = {&a};
          hipError_t e = hipLaunchCooperativeKernel((const void*)fwd_kernel, dim3(grid), dim3(512), args, LDS_BYTES, stream);
          if (e != hipSuccess) fprintf(stderr, "cooperative launch failed: %s (grid %d)\n", hipGetErrorString(e), grid);
      } }
#else
    {
        a.ph_lo = 0; a.ph_hi = N_PHASES;
        void* args[] = {&a};
        hipError_t e = hipLaunchCooperativeKernel((const void*)fwd_kernel, dim3(grid), dim3(512), args, LDS_BYTES, stream);
        if (e != hipSuccess) fprintf(stderr, "cooperative launch failed: %s (grid %d)\n", hipGetErrorString(e), grid);
    }
#endif
}
```
